# Optimizing an MI355X kernel written in HIP

```python
import jax, jax.numpy as jnp
from jax import lax
import numpy as np

D_MODEL = 1024
BATCH = 4
SEQ = 8192
DEPTH = 1

CHUNK = 64
D_MIX = D_MODEL
M_WIDTH = D_MIX // 2
M_HEADS = 4
M_HEAD_DIM = M_WIDTH // M_HEADS
SB_WIDTH = D_MIX - M_WIDTH
SB_HEADS = 8
SB_HEAD_DIM = SB_WIDTH // SB_HEADS
SB_Q_BLOCK = 128
CONV_WIDTH = 4
N_GROUPS = 4
EXPERTS_PER_GROUP = 8
N_EXPERTS = N_GROUPS * EXPERTS_PER_GROUP
TOP_K_IN_GROUP = 2
D_EXPERT = D_MODEL // 2
EXPERT_BLOCK = 128
PLE_DIM = 256
EPS = 1e-6
SPLITS = [M_WIDTH, 2 * M_WIDTH, 3 * M_WIDTH, 4 * M_WIDTH,
          4 * M_WIDTH + M_HEADS, 4 * M_WIDTH + 2 * M_HEADS,
          4 * M_WIDTH + 2 * M_HEADS + SB_WIDTH, 4 * M_WIDTH + 2 * M_HEADS + 2 * SB_WIDTH]
IN_COLS = 4 * M_WIDTH + 2 * M_HEADS + 3 * SB_WIDTH

kernel_name = 'hymba_mlstm_stickbreak_hiermoe_ple'


def rmsnorm(x, g):
    xf = x.astype(jnp.float32)
    y = xf * lax.rsqrt(jnp.mean(xf * xf, axis=-1, keepdims=True) + EPS)
    return (y * g.astype(jnp.float32)).astype(x.dtype)


def causal_conv(x, w):
    K = w.shape[0]
    S = x.shape[1]
    xp = jnp.pad(x, ((0, 0), (K - 1, 0), (0, 0)))
    out = xp[:, 0:S] * w[0]
    for j in range(1, K):
        out = out + xp[:, j:j + S] * w[j]
    return out


def mlstm_chunkwise(q, k, v, i_pre, f_pre):
    B, S, H, D = q.shape
    L = CHUNK
    NC = S // L
    f32 = jnp.float32

    def chunks(t):
        return t.astype(f32).reshape(B, NC, L, H, -1).transpose(0, 1, 3, 2, 4)

    q = chunks(q)
    k = chunks(k) * (D ** -0.5)
    v = chunks(v)
    log_i = i_pre.astype(f32).reshape(B, NC, L, H).transpose(0, 1, 3, 2)
    log_f = jax.nn.log_sigmoid(f_pre.astype(f32)).reshape(B, NC, L, H).transpose(0, 1, 3, 2)
    b = jnp.cumsum(log_f, axis=-1)
    b_last = b[..., -1]

    w_end = b_last[..., None] - b + log_i
    m_loc = jnp.max(w_end, axis=-1)
    e_end = jnp.exp(w_end - m_loc[..., None])
    dC = jnp.einsum('bchs,bchsd,bchse->bchde', e_end, k, v)
    dn = jnp.einsum('bchs,bchsd->bchd', e_end, k)

    def step(carry, xs):
        C, n, m = carry
        dC_c, dn_c, mloc_c, blast_c = xs
        m_new = jnp.maximum(blast_c + m, mloc_c)
        decay = jnp.exp(blast_c + m - m_new)
        scale = jnp.exp(mloc_c - m_new)
        C_new = decay[..., None, None] * C + scale[..., None, None] * dC_c
        n_new = decay[..., None] * n + scale[..., None] * dn_c
        return (C_new, n_new, m_new), (C, n, m)

    init = (jnp.zeros((B, H, D, D), f32), jnp.zeros((B, H, D), f32), jnp.zeros((B, H), f32))
    xs = (jnp.moveaxis(dC, 1, 0), jnp.moveaxis(dn, 1, 0),
          jnp.moveaxis(m_loc, 1, 0), jnp.moveaxis(b_last, 1, 0))
    _, (C_prev, n_prev, m_prev) = lax.scan(step, init, xs)
    C_prev = jnp.moveaxis(C_prev, 0, 1)
    n_prev = jnp.moveaxis(n_prev, 0, 1)
    m_prev = jnp.moveaxis(m_prev, 0, 1)

    causal = jnp.tril(jnp.ones((L, L), dtype=bool))
    log_intra = b[..., :, None] - b[..., None, :] + log_i[..., None, :]
    log_intra = jnp.where(causal, log_intra, -jnp.inf)
    log_inter = b + m_prev[..., None]
    m_t = jnp.maximum(log_inter, jnp.max(log_intra, axis=-1))
    w_qk = jnp.exp(log_intra - m_t[..., None]) * jnp.einsum('bchtd,bchsd->bchts', q, k)
    a_int = jnp.exp(log_inter - m_t)
    num = (jnp.einsum('bchts,bchse->bchte', w_qk, v)
           + a_int[..., None] * jnp.einsum('bchtd,bchde->bchte', q, C_prev))
    den = jnp.sum(w_qk, axis=-1) + a_int * jnp.einsum('bchtd,bchd->bcht', q, n_prev)
    h = num / jnp.maximum(jnp.abs(den), jnp.exp(-m_t))[..., None]
    return h.transpose(0, 1, 3, 2, 4).reshape(B, S, H, D)


def stick_breaking(q, k, v):
    B, S, H, D = q.shape
    f32 = jnp.float32
    q = q.astype(f32).transpose(0, 2, 1, 3) * (D ** -0.5)
    k = k.astype(f32).transpose(0, 2, 1, 3)
    v = v.astype(f32).transpose(0, 2, 1, 3)
    s_idx = jnp.arange(S)

    def block(qb):
        start = qb * SB_Q_BLOCK
        qblk = lax.dynamic_slice_in_dim(q, start, SB_Q_BLOCK, axis=2)
        z = jnp.einsum('bhtd,bhsd->bhts', qblk, k)
        t_idx = start + jnp.arange(SB_Q_BLOCK)
        mask = s_idx[None, :] < t_idx[:, None]
        log_keep = jnp.where(mask, jax.nn.log_sigmoid(-z), 0.0)
        later = lax.cumsum(log_keep, axis=3, reverse=True) - log_keep
        log_a = jnp.where(mask, jax.nn.log_sigmoid(z) + later, -jnp.inf)
        return jnp.einsum('bhts,bhsd->bhtd', jnp.exp(log_a), v)

    o = lax.map(block, jnp.arange(S // SB_Q_BLOCK))
    return o.transpose(1, 0, 3, 2, 4).reshape(B, S, H, D)


def hier_moe(c, w_rg, b_rg, w_re, b_re, w_gate, w_up, w_down):
    B, S, D = c.shape
    T = B * S
    xf = c.reshape(T, D)
    x32 = xf.astype(jnp.float32)
    g_logits = x32 @ w_rg.astype(jnp.float32) + b_rg.astype(jnp.float32)
    g_prob = jax.nn.softmax(g_logits, axis=-1)
    g_sel = jnp.argmax(g_logits, axis=-1).astype(jnp.int32)
    p_g = jnp.take_along_axis(g_prob, g_sel[:, None], axis=1)[:, 0]
    e_logits = (x32 @ w_re.astype(jnp.float32) + b_re.astype(jnp.float32)).reshape(T, N_GROUPS, EXPERTS_PER_GROUP)
    e_sel_logits = jnp.take_along_axis(e_logits, g_sel[:, None, None], axis=1)[:, 0]
    top_v, top_i = lax.top_k(e_sel_logits, TOP_K_IN_GROUP)
    weights = p_g[:, None] * jax.nn.softmax(top_v, axis=-1)
    eids = g_sel[:, None] * EXPERTS_PER_GROUP + top_i.astype(jnp.int32)

    flat_e = eids.reshape(-1)
    flat_w = weights.reshape(-1)
    flat_tok = jnp.repeat(jnp.arange(T, dtype=jnp.int32), TOP_K_IN_GROUP)
    order = jnp.argsort(flat_e, stable=True)
    sorted_e = flat_e[order]
    counts = jnp.bincount(flat_e, length=N_EXPERTS).astype(jnp.int32)
    padded = ((counts + EXPERT_BLOCK - 1) // EXPERT_BLOCK) * EXPERT_BLOCK
    offs = jnp.cumsum(counts) - counts
    pend = jnp.cumsum(padded)
    poffs = pend - padded
    n_assign = T * TOP_K_IN_GROUP
    rank = jnp.arange(n_assign, dtype=jnp.int32) - offs[sorted_e]
    dest = poffs[sorted_e] + rank
    R = n_assign + N_EXPERTS * EXPERT_BLOCK
    NB = R // EXPERT_BLOCK
    buf_tok = jnp.zeros((R,), jnp.int32).at[dest].set(flat_tok[order])
    buf_w = jnp.zeros((R,), jnp.float32).at[dest].set(flat_w[order])
    block_start = jnp.arange(NB, dtype=jnp.int32) * EXPERT_BLOCK
    block_e = jnp.minimum(jnp.searchsorted(pend, block_start, side='right'), N_EXPERTS - 1)
    xin = xf[buf_tok].reshape(NB, EXPERT_BLOCK, D)

    def expert_block(args):
        xb, e = args
        hid = jax.nn.silu(xb @ w_gate[e]) * (xb @ w_up[e])
        return hid @ w_down[e]

    y = lax.map(expert_block, (xin, block_e)).reshape(R, D)
    out = jax.ops.segment_sum(y.astype(jnp.float32) * buf_w[:, None], buf_tok, num_segments=T)
    return out.reshape(B, S, D).astype(c.dtype)


def setup_inputs(seed: int = 0) -> dict:
    key = jax.random.key(seed)
    ks = jax.random.split(key, 24)
    f32 = jnp.float32

    def nrm(k, shape, scale):
        return jax.random.normal(k, shape, f32) * scale

    def gain(k, shape):
        return 1.0 + 0.02 * jax.random.normal(k, shape, f32)

    b_gates = jnp.concatenate([
        0.1 * jax.random.normal(ks[3], (DEPTH, M_HEADS), f32),
        jnp.linspace(3.0, 6.0, M_HEADS, dtype=f32)[None, :] + 0.1 * jax.random.normal(ks[4], (DEPTH, M_HEADS), f32),
    ], axis=-1)
    return {
        'x': nrm(ks[0], (BATCH, SEQ, D_MODEL), 1.0),
        'p': nrm(ks[1], (DEPTH, BATCH, SEQ, PLE_DIM), 1.0),
        'g_mix': gain(ks[2], (DEPTH, D_MODEL)),
        'w_in': nrm(ks[5], (DEPTH, D_MODEL, IN_COLS), D_MODEL ** -0.5),
        'b_gates': b_gates,
        'conv_q': nrm(ks[6], (DEPTH, CONV_WIDTH, M_WIDTH), CONV_WIDTH ** -0.5),
        'conv_k': nrm(ks[7], (DEPTH, CONV_WIDTH, M_WIDTH), CONV_WIDTH ** -0.5),
        'g_mhead': gain(ks[8], (DEPTH, M_WIDTH)),
        'w_out': nrm(ks[9], (DEPTH, D_MIX, D_MODEL), D_MIX ** -0.5),
        'g_ffn': gain(ks[10], (DEPTH, D_MODEL)),
        'w_router_group': nrm(ks[11], (DEPTH, D_MODEL, N_GROUPS), D_MODEL ** -0.5),
        'b_router_group': nrm(ks[12], (DEPTH, N_GROUPS), 0.01),
        'w_router_expert': nrm(ks[13], (DEPTH, D_MODEL, N_EXPERTS), D_MODEL ** -0.5),
        'b_router_expert': nrm(ks[14], (DEPTH, N_EXPERTS), 0.01),
        'w_exp_gate': nrm(ks[15], (DEPTH, N_EXPERTS, D_MODEL, D_EXPERT), D_MODEL ** -0.5),
        'w_exp_up': nrm(ks[16], (DEPTH, N_EXPERTS, D_MODEL, D_EXPERT), D_MODEL ** -0.5),
        'w_exp_down': nrm(ks[17], (DEPTH, N_EXPERTS, D_EXPERT, D_MODEL), D_EXPERT ** -0.5),
        'g_ple': gain(ks[18], (DEPTH, D_MODEL)),
        'w_ple_gate': nrm(ks[19], (DEPTH, D_MODEL, D_MODEL), D_MODEL ** -0.5),
        'w_ple_proj': nrm(ks[20], (DEPTH, PLE_DIM, D_MODEL), PLE_DIM ** -0.5),
        'g_ple_post': gain(ks[21], (DEPTH, D_MODEL)),
        'g_final': gain(ks[22], (D_MODEL,)),
    }


def reference(x, p, g_mix, w_in, b_gates, conv_q, conv_k, g_mhead, w_out, g_ffn,
              w_router_group, b_router_group, w_router_expert, b_router_expert,
              w_exp_gate, w_exp_up, w_exp_down, g_ple, w_ple_gate, w_ple_proj,
              g_ple_post, g_final):
    h = x
    B, S, _ = x.shape
    for l in range(DEPTH):
        a = rmsnorm(h, g_mix[l])
        u = a @ w_in[l]
        mq, mk, mv, mo, mi, mf, sq, sk, sv = jnp.split(u, SPLITS, axis=-1)
        mq = jax.nn.silu(causal_conv(mq, conv_q[l]))
        mk = jax.nn.silu(causal_conv(mk, conv_k[l]))
        i_pre = mi + b_gates[l, :M_HEADS]
        f_pre = mf + b_gates[l, M_HEADS:]
        hm = mlstm_chunkwise(mq.reshape(B, S, M_HEADS, M_HEAD_DIM),
                             mk.reshape(B, S, M_HEADS, M_HEAD_DIM),
                             mv.reshape(B, S, M_HEADS, M_HEAD_DIM), i_pre, f_pre)
        hm = rmsnorm(hm, g_mhead[l].reshape(M_HEADS, M_HEAD_DIM))
        hm = jax.nn.sigmoid(mo.astype(jnp.float32)).reshape(B, S, M_HEADS, M_HEAD_DIM) * hm
        hs = stick_breaking(sq.reshape(B, S, SB_HEADS, SB_HEAD_DIM),
                            sk.reshape(B, S, SB_HEADS, SB_HEAD_DIM),
                            sv.reshape(B, S, SB_HEADS, SB_HEAD_DIM))
        mixed = jnp.concatenate([hm.reshape(B, S, M_WIDTH), hs.reshape(B, S, SB_WIDTH)], axis=-1)
        h = h + mixed.astype(h.dtype) @ w_out[l]
        c = rmsnorm(h, g_ffn[l])
        h = h + hier_moe(c, w_router_group[l], b_router_group[l], w_router_expert[l],
                         b_router_expert[l], w_exp_gate[l], w_exp_up[l], w_exp_down[l])
        gate = jax.nn.sigmoid((rmsnorm(h, g_ple[l]) @ w_ple_gate[l]).astype(jnp.float32))
        ple = rmsnorm(p[l].astype(h.dtype) @ w_ple_proj[l], g_ple_post[l])
        h = h + (gate * ple.astype(jnp.float32)).astype(h.dtype)
    return rmsnorm(h, g_final)
```

```cpp
#define N_LAUNCHES 1
#include <hip/hip_runtime.h>
#include <cstdio>
#include <cstdint>

#ifndef N_LAUNCHES
#define N_LAUNCHES 1
#endif

#define LAS __attribute__((address_space(3)))
typedef unsigned short bf16;
typedef short bf16x8 __attribute__((ext_vector_type(8)));
typedef short s16x4 __attribute__((ext_vector_type(4)));
typedef float f32x4 __attribute__((ext_vector_type(4)));
typedef float f32x2 __attribute__((ext_vector_type(2)));
typedef unsigned u32x4 __attribute__((ext_vector_type(4)));
typedef unsigned u32x2 __attribute__((ext_vector_type(2)));
typedef int v8i32 __attribute__((ext_vector_type(8)));
typedef int v4i32 __attribute__((ext_vector_type(4)));

constexpr int T = 32768, D = 1024, SEQ = 8192, NBATCH = 4;
constexpr int NU = 3584;
constexpr int UQ = 0, UK = 512, UV = 1024, UO = 1536, USQ = 2048, USK = 2560, USV = 3072;
constexpr size_t UGS = (size_t)32768 * 128;
constexpr int GQ = 0, GK = 4, GV = 8, GO = 12, GSQ = 16, GSK = 20, GSV = 24;
constexpr int INC = 3592;
constexpr int NCH = 128;
constexpr int NEXP = 32, DEXP = 512;
constexpr int RMAX = 73728, NPMAX = 288;
constexpr float EPS = 1e-6f;
constexpr int NWAVES = 8, NTHR = 512;

constexpr size_t MiB = 1u << 20;
constexpr size_t WS_CTL = 0, CTL_ZERO_BYTES = 64 * 1024;
constexpr size_t WS_WIN = 1 * MiB, WS_WOUT = 9 * MiB, WS_WPG = 11 * MiB, WS_WPP = 13 * MiB;
constexpr size_t WS_WGU = 14 * MiB, WS_WD = 78 * MiB;
constexpr size_t WS_MISC = 110 * MiB;
constexpr size_t WS_A64 = 116 * MiB;
constexpr size_t WS_U = 180 * MiB;
constexpr size_t WS_XIN = 180 * MiB, WS_HID = 324 * MiB, WS_G = 324 * MiB;
constexpr size_t WS_WIN8 = 94 * MiB;
constexpr size_t WS_H2Q = 46 * MiB;
constexpr size_t WS_H8 = 180 * MiB;
constexpr float S8_W = 64.f, S8_H1 = 8.f, S8_HID = 8.f, S8_Y = 32.f;
constexpr size_t WS_C = 404 * MiB;
constexpr size_t WS_HB = 404 * MiB;
constexpr size_t WS_PB = 468 * MiB;
constexpr size_t WS_MISC2 = 484 * MiB;
constexpr size_t WS_END = 488 * MiB;
constexpr size_t MS_GATES = WS_MISC;
constexpr size_t MS_DN = MS_GATES + (size_t)T * 8 * 4;
constexpr size_t MS_MLOC = MS_DN + 2048 * 128 * 4;
constexpr size_t MS_BLAST = MS_MLOC + 2048 * 4;
constexpr size_t MS_MPREV = MS_BLAST + 2048 * 4;
constexpr size_t MS_WRGT = MS_MPREV + 2048 * 4;
constexpr size_t MS_WRET = MS_WRGT + 4 * 1024 * 4;
constexpr size_t MS_RE = MS_WRET + 32 * 1024 * 4;
constexpr size_t MS_RW = MS_RE + (size_t)T * 2 * 4;
constexpr size_t MS_POS = MS_RW + (size_t)T * 2 * 4;
constexpr size_t MS_CNT = MS_POS + (size_t)T * 2 * 4;
constexpr size_t MS_ROWW = MS_CNT + 256 * 32 * 4;
constexpr size_t MS_PANE = MS_ROWW + (size_t)RMAX * 4;
constexpr size_t MS_R1 = MS_PANE + 4096;
constexpr size_t MS_R2 = MS_R1 + (size_t)T * 4;
constexpr size_t MS_ROWR = MS_R2 + (size_t)T * 4;
constexpr size_t MS_END = MS_ROWR + (size_t)RMAX * 4;
constexpr size_t MS_GS = WS_MISC2;
constexpr size_t MS_CH = MS_GS + (size_t)T * 16 * 4;
constexpr size_t MS_WRH = MS_CH + 512 * 8 * 4;
constexpr size_t MS_WRL = MS_WRH + 48 * 1024 * 2;
constexpr size_t MS_ROWTOK = MS_WRL + 48 * 1024 * 2;
constexpr size_t MS2_END = MS_ROWTOK + (size_t)RMAX * 4;
static_assert(MS2_END <= WS_END, "misc region 2");
static_assert(MS_END <= WS_A64, "misc region");
constexpr int CW_BAR = 1024;

constexpr int RING_BYTES = 131072;
constexpr int MISC_OFF = 147456 - 128;
constexpr int LDS_BYTES = 147456;

#define LDS_WAIT() asm volatile("s_waitcnt lgkmcnt(0)" ::: "memory")
#define VM_WAIT() asm volatile("s_waitcnt vmcnt(0)" ::: "memory")
__device__ __forceinline__ unsigned f2bf(float f) { unsigned u = __builtin_bit_cast(unsigned, f); return (u + 0x7fffu + ((u >> 16) & 1u)) >> 16; }
typedef __bf16 bf16x2_t __attribute__((ext_vector_type(2)));
__device__ __forceinline__ unsigned pk2(float lo, float hi) { const f32x2 v = {lo, hi}; return __builtin_bit_cast(unsigned, __builtin_convertvector(v, bf16x2_t)); }
__device__ __forceinline__ float bf2f(unsigned b) { return __builtin_bit_cast(float, b << 16); }
__device__ __forceinline__ float bflo(unsigned w) { return __builtin_bit_cast(float, w << 16); }
__device__ __forceinline__ float bfhi(unsigned w) { return __builtin_bit_cast(float, w & 0xffff0000u); }
__device__ __forceinline__ unsigned pk4_fp8(float a, float b, float c, float d) {
    a = __builtin_amdgcn_fmed3f(a, -448.f, 448.f); b = __builtin_amdgcn_fmed3f(b, -448.f, 448.f); c = __builtin_amdgcn_fmed3f(c, -448.f, 448.f); d = __builtin_amdgcn_fmed3f(d, -448.f, 448.f);
    int p = 0; p = __builtin_amdgcn_cvt_pk_fp8_f32(a, b, p, false); p = __builtin_amdgcn_cvt_pk_fp8_f32(c, d, p, true); return (unsigned)p; }
__device__ __forceinline__ float wave_sum(float v) {
    int x = __builtin_bit_cast(int, v);
#define WS_STEP(ctrl, rmask) { const int y = __builtin_amdgcn_update_dpp(0, x, ctrl, rmask, 0xf, true); x = __builtin_bit_cast(int, __builtin_bit_cast(float, x) + __builtin_bit_cast(float, y)); }
    WS_STEP(0xB1, 0xf)
    WS_STEP(0x4E, 0xf)
    WS_STEP(0x141, 0xf)
    WS_STEP(0x140, 0xf)
    WS_STEP(0x142, 0xa)
    WS_STEP(0x143, 0xc)
#undef WS_STEP
    return __builtin_bit_cast(float, __builtin_amdgcn_readlane(x, 63));
}
__device__ __forceinline__ float wave_max(float v) {
#pragma unroll
    for (int o = 1; o < 64; o <<= 1) v = fmaxf(v, __shfl_xor(v, o));
    return v;
}
__device__ __forceinline__ float sigmoidf_(float x) { return __builtin_amdgcn_rcpf(1.f + __builtin_amdgcn_exp2f(-1.4426950408889634f * x)); }
__device__ __forceinline__ float sigmoid_fast(float x) { return __builtin_amdgcn_rcpf(1.f + __builtin_amdgcn_exp2f(-1.4426950408889634f * x)); }
__device__ __forceinline__ float siluf_(float x) { return x * __builtin_amdgcn_rcpf(1.f + __builtin_amdgcn_exp2f(-1.4426950408889634f * x)); }
__device__ __forceinline__ float log_sigmoidf_(float x) { return fminf(x, 0.f) - log1pf(__expf(-fabsf(x))); }

#define MFMA16(a, b, c) __builtin_amdgcn_mfma_f32_16x16x32_bf16((a), (b), (c), 0, 0, 0)

#define XB_TMO      128
#define XB_XCNT(j)  (256  + 64 * (j))
#define XB_XSUB(j)  (1280 + 64 * (j))
#define XB_XGEN(j)  (2304 + 64 * (j))
#define XB_TOP      3328
#define XB_TOPGEN   3392
#define XCD_BAR_WORDS 3456
#define XB_SPIN_CAP (1u << 18)
__device__ __forceinline__ unsigned xb_ld(unsigned* p)              { return __hip_atomic_load(p, __ATOMIC_RELAXED, __HIP_MEMORY_SCOPE_AGENT); }
__device__ __forceinline__ unsigned xb_add(unsigned* p, unsigned v) { return __hip_atomic_fetch_add(p, v, __ATOMIC_RELAXED, __HIP_MEMORY_SCOPE_AGENT); }
__device__ __forceinline__ unsigned xb_xcc_id() { return (unsigned)__builtin_amdgcn_s_getreg((3 << 11) | 20) & 0xFu; }
#define XB_SPIN(cond, bar) do { unsigned _sp = 0; while (cond) { __builtin_amdgcn_s_sleep(1); \
    if ((++_sp & 255u) == 0u) { if (xb_ld(&(bar)[XB_TMO])) break; if (_sp > XB_SPIN_CAP) { atomicAdd(&(bar)[XB_TMO], 1u); break; } } } } while (0)
struct XcdBarrier { unsigned* bar; unsigned x; volatile LAS unsigned* st; };
__device__ __forceinline__ XcdBarrier xcd_barrier_post(unsigned* bar, volatile LAS unsigned* st) {
    XcdBarrier b; b.bar = bar; b.x = xb_xcc_id(); b.st = st;
    if (threadIdx.x == 0) (void)xb_add(&bar[XB_XCNT(b.x)], 1u);
    return b;
}
__device__ __forceinline__ void xcd_barrier_complete(unsigned* bar, unsigned x, unsigned& nloc, unsigned& nx) {
    const unsigned G = gridDim.x * gridDim.y * gridDim.z;
    unsigned sum, cnt, mine, sp = 0u;
    for (;;) {
        sum = 0u; cnt = 0u; mine = 0u;
#pragma unroll
        for (unsigned j = 0; j < 16; ++j) { const unsigned c = xb_ld(&bar[XB_XCNT(j)]); sum += c; cnt += (c > 0u) ? 1u : 0u; mine = (j == x) ? c : mine; }
        if (sum == G) break;
        __builtin_amdgcn_s_sleep(1);
        if ((++sp & 255u) == 0u) { if (xb_ld(&bar[XB_TMO])) break; if (sp > XB_SPIN_CAP) { atomicAdd(&bar[XB_TMO], 1u); break; } }
    }
    nloc = mine > 0u ? mine : 1u; nx = cnt > 0u ? cnt : 1u;
}
__device__ __forceinline__ void xcd_barrier(const XcdBarrier& b) {
    asm volatile("s_waitcnt vmcnt(0)" ::: "memory");
    __syncthreads();
    if (threadIdx.x == 0) {
        unsigned* bar = b.bar;
        __builtin_amdgcn_s_waitcnt(0);
        unsigned nloc = b.st[0], nx = b.st[1];
        if (nloc == 0u) { xcd_barrier_complete(bar, b.x, nloc, nx); b.st[0] = nloc; b.st[1] = nx; }
        const unsigned old = xb_add(&bar[XB_XSUB(b.x)], 1u);
        const unsigned gen = old / nloc;
        if (old + 1u == (gen + 1u) * nloc) {
            __builtin_amdgcn_fence(__ATOMIC_RELEASE, "agent");
            asm volatile("s_waitcnt vmcnt(0)" ::: "memory");
            const unsigned og = xb_add(&bar[XB_TOP], 1u);
            const unsigned tg = og / nx;
            if (og + 1u == (tg + 1u) * nx) xb_add(&bar[XB_TOPGEN], 1u);
            else XB_SPIN(xb_ld(&bar[XB_TOPGEN]) == tg, bar);
            __builtin_amdgcn_fence(__ATOMIC_ACQUIRE, "agent");
            xb_add(&bar[XB_XGEN(b.x)], 1u);
            asm volatile("s_waitcnt vmcnt(0)" ::: "memory");
        } else {
            XB_SPIN(xb_ld(&bar[XB_XGEN(b.x)]) == gen, bar);
            __builtin_amdgcn_fence(__ATOMIC_ACQUIRE, "agent");
            asm volatile("s_waitcnt vmcnt(0)" ::: "memory");
        }
    }
    __syncthreads();
}

namespace pg8 {
constexpr int BM = 256, BK = 64, HALF = 128, HTB = HALF * BK * 2, STAGE_BYTES = 8 * HTB;
__device__ __forceinline__ int lds_byte(int r, int c) { const int st = (r >> 4) * 2 + (c >> 5), rr = r & 15, cc = c & 31, ob = rr * 64 + cc * 2; return st * 1024 + (ob ^ (((ob >> 9) & 1) << 5)); }
__device__ __forceinline__ void stage_rc(int b, int& R, int& C) { const int st = b / 1024, sb = b % 1024, swz = sb ^ (((sb >> 9) & 1) << 5); R = (st >> 1) * 16 + swz / 64; C = (st & 1) * 32 + (swz % 64) / 2; }
__device__ __forceinline__ int perm32(int rho) { const int n = rho >> 4, i = rho & 15; return 8 * (i >> 2) + 4 * n + (i & 3); }
struct Unit { int pm, pn; const char* A; const char* B; int kind; const LAS int* gidx; };
__device__ __forceinline__ unsigned cvt_pk_bf16(float lo, float hi) { return pk2(lo, hi); }

template <bool GATHER, class Epi, class Sched>
__device__ __forceinline__ void gemm_phase(LAS unsigned char* lds, const int K, const Sched& S, const Epi& E) {
    int tid = threadIdx.x; asm volatile("" : "+v"(tid));
    const int wid = __builtin_amdgcn_readfirstlane(tid >> 6), lane = tid & 63, wr = wid >> 2, wc = wid & 3, fr = lane & 15, fq = lane >> 4;
    const int nt = K / BK;
    unsigned voffA[GATHER ? 2 : 1][2], voffB[2];
    const size_t kstep = (size_t)(BK * 2);
    const size_t hstep = (size_t)HALF * K * 2;
    const size_t ahs = GATHER ? 0 : hstep;
    constexpr int H1 = GATHER ? 1 : 0;
#pragma unroll
    for (int i = 0; i < 2; ++i) { int R, C; stage_rc(tid * 16 + i * 8192, R, C); const int Rb = Epi::PERM ? ((R & ~31) + perm32(R & 31)) : R;
        voffA[0][i] = (unsigned)(R * K + C) * 2u; voffB[i] = (unsigned)(Rb * K + C) * 2u; }
    const unsigned ldsw = (unsigned)wid * 1024u;
    const int aoff = lds_byte(wr * 64 + fr, fq * 8), boff = lds_byte(wc * 32 + fr, fq * 8);
#define PG8_SA(b, h) (((b) * 2 + (h)) * HTB)
#define PG8_SB(b, h) ((4 + (b) * 2 + (h)) * HTB)
#define PG8_STAGE(bufoff, gbase, voff) do { _Pragma("unroll") for (int _i = 0; _i < 2; ++_i) \
        __builtin_amdgcn_global_load_lds((const unsigned*)((const char*)(gbase) + (voff)[_i]), (LAS unsigned*)(lds + (bufoff) + ldsw + _i * 8192), 16, 0, 0); } while (0)
#define PG8_LDA(dst, b, h) do { _Pragma("unroll") for (int m = 0; m < 4; ++m) _Pragma("unroll") for (int k = 0; k < 2; ++k) dst[m][k] = *(const LAS bf16x8*)(lds + PG8_SA(b, h) + aoff + m * 2048 + k * 1024); } while (0)
#define PG8_LDB(dst, b, h) do { _Pragma("unroll") for (int n = 0; n < 2; ++n) _Pragma("unroll") for (int k = 0; k < 2; ++k) dst[n][k] = *(const LAS bf16x8*)(lds + PG8_SB(b, h) + boff + n * 2048 + k * 1024); } while (0)
#define PG8_MMA(ai, bj, At, Bt) do { __builtin_amdgcn_s_setprio(1); _Pragma("unroll") for (int m = 0; m < 4; ++m) _Pragma("unroll") for (int n = 0; n < 2; ++n) _Pragma("unroll") for (int k = 0; k < 2; ++k) \
        acc[ai][bj][m][n] = __builtin_amdgcn_mfma_f32_16x16x32_bf16(Bt[n][k], At[m][k], acc[ai][bj][m][n], 0, 0, 0); __builtin_amdgcn_s_setprio(0); } while (0)
#define PG8_WAIT_V(n) asm volatile("s_waitcnt vmcnt(" #n ")" ::: "memory")
#define PG8_WAIT_L(n) asm volatile("s_waitcnt lgkmcnt(" #n ")" ::: "memory")
#define PG8_BAR __builtin_amdgcn_s_barrier()
#define PG8_SCHED __builtin_amdgcn_sched_barrier(0)
    Unit cur, nxt; int ui = 0;
    if (!S.next(0, cur)) return;
    f32x4 acc[2][2][4][2];
#pragma unroll
    for (int a = 0; a < 2; ++a)
#pragma unroll
        for (int b = 0; b < 2; ++b)
#pragma unroll
            for (int m = 0; m < 4; ++m)
#pragma unroll
                for (int n = 0; n < 2; ++n) acc[a][b][m][n] = (f32x4){0.f, 0.f, 0.f, 0.f};
    bf16x8 At[4][2], B0[2][2], B1[2][2];
    int gi[2][2];
    if (GATHER) {
#pragma unroll
        for (int i = 0; i < 2; ++i) { int R, C; stage_rc(tid * 16 + i * 8192, R, C); const int g0 = cur.gidx[R], g1 = cur.gidx[HALF + R];
            voffA[0][i] = (unsigned)(g0 * K + C) * 2u; voffA[H1][i] = (unsigned)(g1 * K + C) * 2u; } }
    const char* cA = cur.A; const char* cB = cur.B;
    PG8_STAGE(PG8_SB(0, 0), cB, voffB); PG8_STAGE(PG8_SB(0, 1), cB + hstep, voffB); PG8_STAGE(PG8_SA(0, 0), cA, voffA[0]); PG8_STAGE(PG8_SA(0, 1), cA + ahs, voffA[H1]);
    if (wr == 1) PG8_BAR;
    PG8_WAIT_V(2); PG8_BAR;
    PG8_STAGE(PG8_SB(1, 0), cB + kstep, voffB); PG8_STAGE(PG8_SA(1, 0), cA + kstep, voffA[0]); PG8_STAGE(PG8_SB(1, 1), cB + hstep + kstep, voffB);
    PG8_WAIT_V(6); PG8_BAR;
    for (;;) {
        const bool has_next = S.next(ui + 1, nxt);
        const char* nA = has_next ? nxt.A : cA; const char* nB = has_next ? nxt.B : cB;
        if (GATHER && has_next) {
#pragma unroll
            for (int i = 0; i < 2; ++i) { int R, C; stage_rc(tid * 16 + i * 8192, R, C); gi[0][i] = nxt.gidx[R]; gi[1][i] = nxt.gidx[HALF + R]; } }
        for (int t = 0; t < nt; t += 2) {
            const bool last = (t == nt - 2);
            const char* a1 = cA + (size_t)(t + 1) * kstep;
            const char* a2 = last ? nA : cA + (size_t)(t + 2) * kstep; const char* b2 = last ? nB : cB + (size_t)(t + 2) * kstep;
            const char* a3 = a2 + kstep; const char* b3 = b2 + kstep;
            PG8_LDB(B0, 0, 0); PG8_LDB(B1, 0, 1); PG8_SCHED; PG8_LDA(At, 0, 0); PG8_STAGE(PG8_SA(1, 1), a1 + ahs, voffA[H1]);
            if (GATHER && last && has_next) {
#pragma unroll
                for (int i = 0; i < 2; ++i) { int R, C; stage_rc(tid * 16 + i * 8192, R, C);
                    voffA[0][i] = (unsigned)(gi[0][i] * K + C) * 2u; voffA[H1][i] = (unsigned)(gi[1][i] * K + C) * 2u; } }
            PG8_WAIT_V(8); PG8_WAIT_L(0); PG8_BAR; PG8_MMA(0, 0, At, B0); PG8_MMA(0, 1, At, B1); PG8_BAR; PG8_SCHED;
            PG8_LDA(At, 0, 1); PG8_STAGE(PG8_SB(0, 0), b2, voffB); PG8_STAGE(PG8_SB(0, 1), b2 + hstep, voffB); PG8_STAGE(PG8_SA(0, 0), a2, voffA[0]);
            PG8_WAIT_V(8); PG8_WAIT_L(0); PG8_BAR; PG8_MMA(1, 0, At, B0); PG8_MMA(1, 1, At, B1); PG8_BAR; PG8_SCHED;
            PG8_LDB(B0, 1, 0); PG8_LDB(B1, 1, 1); PG8_SCHED; PG8_LDA(At, 1, 0); PG8_STAGE(PG8_SA(0, 1), a2 + ahs, voffA[H1]);
            PG8_WAIT_V(8); PG8_WAIT_L(0); PG8_BAR; PG8_MMA(0, 0, At, B0); PG8_MMA(0, 1, At, B1); PG8_BAR; PG8_SCHED;
            PG8_LDA(At, 1, 1); PG8_STAGE(PG8_SB(1, 0), b3, voffB); PG8_STAGE(PG8_SB(1, 1), b3 + hstep, voffB); PG8_STAGE(PG8_SA(1, 0), a3, voffA[0]);
            PG8_WAIT_V(8); PG8_WAIT_L(0); PG8_BAR; PG8_MMA(1, 0, At, B0); PG8_MMA(1, 1, At, B1); PG8_BAR; PG8_SCHED;
        }
        if (wr == 0) PG8_BAR;
        E(acc, cur, wr, wc, fr, fq);
        if (!has_next) break;
#pragma unroll
        for (int a = 0; a < 2; ++a)
#pragma unroll
            for (int b = 0; b < 2; ++b)
#pragma unroll
                for (int m = 0; m < 4; ++m)
#pragma unroll
                    for (int n = 0; n < 2; ++n) acc[a][b][m][n] = (f32x4){0.f, 0.f, 0.f, 0.f};
        cur = nxt; cA = nA; cB = nB; ++ui;
        if (wr == 1) PG8_BAR;
    }
    PG8_WAIT_V(0);
    PG8_BAR;
#undef PG8_SA
#undef PG8_SB
#undef PG8_STAGE
#undef PG8_LDA
#undef PG8_LDB
#undef PG8_MMA
#undef PG8_WAIT_V
#undef PG8_WAIT_L
#undef PG8_BAR
#undef PG8_SCHED
}

template <bool GATHER, class Epi, class Sched>
__device__ __forceinline__ void gemm_phase_fp8(LAS unsigned char* lds, const int K, const Sched& S, const Epi& E) {
    int tid = threadIdx.x; asm volatile("" : "+v"(tid));
    const int wid = __builtin_amdgcn_readfirstlane(tid >> 6), lane = tid & 63, wr = wid >> 2, wc = wid & 3, fr = lane & 15, fq = lane >> 4;
    const int nt = K / BK;
    unsigned voffA[GATHER ? 2 : 1][2], voffB[2];
    const size_t kstep = (size_t)(BK * 2);
    const size_t hstep = (size_t)HALF * K * 2;
    const size_t ahs = GATHER ? 0 : hstep;
    constexpr int H1 = GATHER ? 1 : 0;
#pragma unroll
    for (int i = 0; i < 2; ++i) { int R, C; stage_rc(tid * 16 + i * 8192, R, C); const int Rb = Epi::PERM ? ((R & ~31) + perm32(R & 31)) : R;
        voffA[0][i] = (unsigned)(R * K + C) * 2u; voffB[i] = (unsigned)(Rb * K + C) * 2u; }
    const unsigned ldsw = (unsigned)wid * 1024u;
    const int aoff = lds_byte(wr * 64 + fr, fq * 8), boff = lds_byte(wc * 32 + fr, fq * 8);
#define PG8_SA(b, h) (((b) * 2 + (h)) * HTB)
#define PG8_SB(b, h) ((4 + (b) * 2 + (h)) * HTB)
#define PG8_STAGE(bufoff, gbase, voff) do { _Pragma("unroll") for (int _i = 0; _i < 2; ++_i) \
        __builtin_amdgcn_global_load_lds((const unsigned*)((const char*)(gbase) + (voff)[_i]), (LAS unsigned*)(lds + (bufoff) + ldsw + _i * 8192), 16, 0, 0); } while (0)
#define PG8_LD8(addr) __builtin_shufflevector(*(const LAS v4i32*)(addr), *(const LAS v4i32*)((addr) + 1024), 0, 1, 2, 3, 4, 5, 6, 7)
#define PG8_LDA(dst, b, h) do { _Pragma("unroll") for (int m = 0; m < 4; ++m) dst[m] = PG8_LD8(lds + PG8_SA(b, h) + aoff + m * 2048); } while (0)
#define PG8_LDB(dst, b, h) do { _Pragma("unroll") for (int n = 0; n < 2; ++n) dst[n] = PG8_LD8(lds + PG8_SB(b, h) + boff + n * 2048); } while (0)
#define PG8_MMA(ai, bj, At, Bt) do { __builtin_amdgcn_s_setprio(1); _Pragma("unroll") for (int m = 0; m < 4; ++m) _Pragma("unroll") for (int n = 0; n < 2; ++n) \
        acc[ai][bj][m][n] = __builtin_amdgcn_mfma_scale_f32_16x16x128_f8f6f4(Bt[n], At[m], acc[ai][bj][m][n], 0, 0, 0, 0x7F7F7F7F, 0, 0x7F7F7F7F); __builtin_amdgcn_s_setprio(0); } while (0)
#define PG8_WAIT_V(n) asm volatile("s_waitcnt vmcnt(" #n ")" ::: "memory")
#define PG8_WAIT_L(n) asm volatile("s_waitcnt lgkmcnt(" #n ")" ::: "memory")
#define PG8_BAR __builtin_amdgcn_s_barrier()
#define PG8_SCHED __builtin_amdgcn_sched_barrier(0)
    Unit cur, nxt; int ui = 0;
    if (!S.next(0, cur)) return;
    f32x4 acc[2][2][4][2];
#pragma unroll
    for (int a = 0; a < 2; ++a)
#pragma unroll
        for (int b = 0; b < 2; ++b)
#pragma unroll
            for (int m = 0; m < 4; ++m)
#pragma unroll
                for (int n = 0; n < 2; ++n) acc[a][b][m][n] = (f32x4){0.f, 0.f, 0.f, 0.f};
    v8i32 At[4], B0[2], B1[2];
    int gi[2][2];
    if (GATHER) {
#pragma unroll
        for (int i = 0; i < 2; ++i) { int R, C; stage_rc(tid * 16 + i * 8192, R, C); const int g0 = cur.gidx[R], g1 = cur.gidx[HALF + R];
            voffA[0][i] = (unsigned)(g0 * K + C) * 2u; voffA[H1][i] = (unsigned)(g1 * K + C) * 2u; } }
    const char* cA = cur.A; const char* cB = cur.B;
    PG8_STAGE(PG8_SB(0, 0), cB, voffB); PG8_STAGE(PG8_SB(0, 1), cB + hstep, voffB); PG8_STAGE(PG8_SA(0, 0), cA, voffA[0]); PG8_STAGE(PG8_SA(0, 1), cA + ahs, voffA[H1]);
    if (wr == 1) PG8_BAR;
    PG8_WAIT_V(2); PG8_BAR;
    PG8_STAGE(PG8_SB(1, 0), cB + kstep, voffB); PG8_STAGE(PG8_SA(1, 0), cA + kstep, voffA[0]); PG8_STAGE(PG8_SB(1, 1), cB + hstep + kstep, voffB);
    PG8_WAIT_V(6); PG8_BAR;
    for (;;) {
        const bool has_next = S.next(ui + 1, nxt);
        const char* nA = has_next ? nxt.A : cA; const char* nB = has_next ? nxt.B : cB;
        if (GATHER && has_next) {
#pragma unroll
            for (int i = 0; i < 2; ++i) { int R, C; stage_rc(tid * 16 + i * 8192, R, C); gi[0][i] = nxt.gidx[R]; gi[1][i] = nxt.gidx[HALF + R]; } }
        for (int t = 0; t < nt; t += 2) {
            const bool last = (t == nt - 2);
            const char* a1 = cA + (size_t)(t + 1) * kstep;
            const char* a2 = last ? nA : cA + (size_t)(t + 2) * kstep; const char* b2 = last ? nB : cB + (size_t)(t + 2) * kstep;
            const char* a3 = a2 + kstep; const char* b3 = b2 + kstep;
            PG8_LDB(B0, 0, 0); PG8_LDB(B1, 0, 1); PG8_SCHED; PG8_LDA(At, 0, 0); PG8_STAGE(PG8_SA(1, 1), a1 + ahs, voffA[H1]);
            if (GATHER && last && has_next) {
#pragma unroll
                for (int i = 0; i < 2; ++i) { int R, C; stage_rc(tid * 16 + i * 8192, R, C);
                    voffA[0][i] = (unsigned)(gi[0][i] * K + C) * 2u; voffA[H1][i] = (unsigned)(gi[1][i] * K + C) * 2u; } }
            PG8_WAIT_V(8); PG8_WAIT_L(0); PG8_BAR; PG8_MMA(0, 0, At, B0); PG8_MMA(0, 1, At, B1); PG8_BAR; PG8_SCHED;
            PG8_LDA(At, 0, 1); PG8_STAGE(PG8_SB(0, 0), b2, voffB); PG8_STAGE(PG8_SB(0, 1), b2 + hstep, voffB); PG8_STAGE(PG8_SA(0, 0), a2, voffA[0]);
            PG8_WAIT_V(8); PG8_WAIT_L(0); PG8_BAR; PG8_MMA(1, 0, At, B0); PG8_MMA(1, 1, At, B1); PG8_BAR; PG8_SCHED;
            PG8_LDB(B0, 1, 0); PG8_LDB(B1, 1, 1); PG8_SCHED; PG8_LDA(At, 1, 0); PG8_STAGE(PG8_SA(0, 1), a2 + ahs, voffA[H1]);
            PG8_WAIT_V(8); PG8_WAIT_L(0); PG8_BAR; PG8_MMA(0, 0, At, B0); PG8_MMA(0, 1, At, B1); PG8_BAR; PG8_SCHED;
            PG8_LDA(At, 1, 1); PG8_STAGE(PG8_SB(1, 0), b3, voffB); PG8_STAGE(PG8_SB(1, 1), b3 + hstep, voffB); PG8_STAGE(PG8_SA(1, 0), a3, voffA[0]);
            PG8_WAIT_V(8); PG8_WAIT_L(0); PG8_BAR; PG8_MMA(1, 0, At, B0); PG8_MMA(1, 1, At, B1); PG8_BAR; PG8_SCHED;
        }
        if (wr == 0) PG8_BAR;
        E(acc, cur, wr, wc, fr, fq);
        if (!has_next) break;
#pragma unroll
        for (int a = 0; a < 2; ++a)
#pragma unroll
            for (int b = 0; b < 2; ++b)
#pragma unroll
                for (int m = 0; m < 4; ++m)
#pragma unroll
                    for (int n = 0; n < 2; ++n) acc[a][b][m][n] = (f32x4){0.f, 0.f, 0.f, 0.f};
        cur = nxt; cA = nA; cB = nB; ++ui;
        if (wr == 1) PG8_BAR;
    }
    PG8_WAIT_V(0);
    PG8_BAR;
#undef PG8_SA
#undef PG8_SB
#undef PG8_STAGE
#undef PG8_LDA
#undef PG8_LDB
#undef PG8_MMA
#undef PG8_LD8
#undef PG8_WAIT_V
#undef PG8_WAIT_L
#undef PG8_BAR
#undef PG8_SCHED
}

struct DenseOrder {
    int nM, nN, nwg, G, c, K; const char* A; const char* B; size_t tstep;
    int psplit = 1 << 30, poff_lo = 0, poff_hi = 0;
    __device__ __forceinline__ void init(int M, int N, int K_, int G_, int c_, const void* A_, const void* B_) { nM = M / BM; nN = N / BM; nwg = nM * nN; G = G_; c = c_; K = K_; A = (const char*)A_; B = (const char*)B_; tstep = (size_t)BM * K * 2; }
    __device__ __forceinline__ bool next(int i, Unit& u) const {
        const long L = (long)i * G + c; if (L >= nwg) return false;
        int wgid = (int)L; { const int q = nwg / 8, r = nwg % 8, xcd = wgid % 8, off = wgid / 8; wgid = (xcd < r ? xcd * (q + 1) : r * (q + 1) + (xcd - r) * q) + off; }
        const int nig = 8 * nN, gid = wgid / nig, fm = gid * 8, gsz = (nM - fm) < 8 ? (nM - fm) : 8;
        u.pm = fm + ((wgid % nig) % gsz); u.pn = (wgid % nig) / gsz; u.pn += (u.pn < psplit) ? poff_lo : poff_hi;
        u.A = A + (size_t)u.pm * tstep; u.B = B + (size_t)u.pn * tstep; u.kind = 0; u.gidx = (const LAS int*)0; return true;
    }
};
template <int NT> struct DenseOrderG : DenseOrder {
    LAS int* tbl;
    __device__ __forceinline__ void preload() const {
#pragma unroll
        for (int i = 0; i < NT; ++i) { Unit u; if (DenseOrder::next(i, u) && threadIdx.x < 256) tbl[256 * i + threadIdx.x] = u.pm * 256 + threadIdx.x; }
        __syncthreads();
    }
    __device__ __forceinline__ bool next(int i, Unit& u) const {
        if (i >= NT || !DenseOrder::next(i, u)) return false;
        u.A = A; u.gidx = tbl + 256 * i; return true;
    }
};
template <int NN, int NT> struct SimpleOrderG {
    int nM, G, c0; const char* A; const char* B; size_t btstep; int psplit, poff_lo, poff_hi; LAS int* tbl;
    __device__ __forceinline__ void preload() const {
        const int c = (c0 & 7) * (G >> 3) + (c0 >> 3);
#pragma unroll
        for (int i = 0; i < NT; ++i) { const int L = i * G + c; if (L < nM * NN && threadIdx.x < 256) tbl[256 * i + threadIdx.x] = (L / NN) * 256 + threadIdx.x; }
        __syncthreads();
    }
    __device__ __forceinline__ bool next(int i, Unit& u) const {
        const int c = (c0 & 7) * (G >> 3) + (c0 >> 3);
        const int L = i * G + c; if (i >= NT || L >= nM * NN) return false;
        u.pm = L / NN; u.pn = L % NN; u.pn += (u.pn < psplit) ? poff_lo : poff_hi;
        u.A = A; u.B = B + (size_t)u.pn * btstep; u.kind = 0; u.gidx = tbl + 256 * i; return true;
    }
};
struct MoeOrder {
    int nunits, G, c0; const int* pane; const char* A; const char* B; size_t atstep, btstep, estep;
    const int* rowtok;
    LAS int* tbl;
    bool ident;
    __device__ __forceinline__ void preload() const {
        const int c = (c0 & 7) * (G >> 3) + (c0 >> 3), t = threadIdx.x;
#pragma unroll
        for (int i = 0; i < 6; ++i) { const int L = i * G + c;
            if (L < nunits) { const int pm = L >> 2;
                if (t == 256 + i) tbl[i] = pane[1 + pm];
                if (rowtok && t < 256) tbl[8 + 256 * i + t] = rowtok[pm * 256 + t];
                if (ident && t < 256) tbl[8 + 256 * i + t] = pm * 256 + t; } }
        __syncthreads();
    }
    __device__ __forceinline__ bool next(int i, Unit& u) const {
        const int c = (c0 & 7) * (G >> 3) + (c0 >> 3);
        const int L = i * G + c; if (L >= nunits || i >= 6) return false;
        u.pm = L >> 2; u.pn = L & 3; const int e = __builtin_amdgcn_readfirstlane(tbl[i]);
        u.A = (rowtok || ident) ? A : A + (size_t)u.pm * atstep; u.gidx = tbl + 8 + 256 * i;
        u.B = B + (size_t)e * estep + (size_t)u.pn * btstep; u.kind = 0; return true;
    }
};
struct FillOrder {
    int nunits, f0, nfill, G, c0, K2; const char* A2; const char* B2;
    __device__ __forceinline__ bool next(int i, Unit& u) const {
        const int c = (c0 & 7) * (G >> 3) + (c0 >> 3);
        const int r = nunits % G; if (c < r) return false;
        const int j = f0 + (c - r) + i * (G - r); if (j >= nfill) return false;
        u.pm = j >> 2; u.pn = j & 3; u.A = A2 + (size_t)u.pm * BM * K2 * 2; u.B = B2 + (size_t)u.pn * BM * K2 * 2; u.kind = 1; u.gidx = (const LAS int*)0; return true;
    }
};

template <int ACT  > struct EpiBf16 {
    static constexpr bool PERM = true;
    bf16* O; int ldc; const float* rs; float rmul; size_t gstride;
    __device__ __forceinline__ void operator()(const f32x4 (&acc)[2][2][4][2], const Unit& u, int wr, int wc, int fr, int fq) const {
        const int row0 = u.pm * BM + wr * 64 + fr; const int col0 = gstride ? wc * 32 + 8 * fq : u.pn * BM + wc * 32 + 8 * fq;
        const size_t bjs = gstride ? gstride : (size_t)HALF; bf16* const Ob = O + (gstride ? (size_t)(2 * u.pn) * gstride : 0);
        float rsv[2][4];
#pragma unroll
        for (int ai = 0; ai < 2; ++ai)
#pragma unroll
            for (int m = 0; m < 4; ++m) rsv[ai][m] = (ACT == 1) ? rs[row0 + ai * HALF + m * 16] * rmul : 1.f;
#pragma unroll
        for (int ai = 0; ai < 2; ++ai)
#pragma unroll
            for (int m = 0; m < 4; ++m) { const int row = row0 + ai * HALF + m * 16; bf16* rowp = Ob + (size_t)row * ldc + col0; const float rsc = rsv[ai][m];
#pragma unroll
                for (int bj = 0; bj < 2; ++bj) { f32x4 v0 = acc[ai][bj][m][0], v1 = acc[ai][bj][m][1];
                    if (ACT == 1) {
#pragma unroll
                        for (int j = 0; j < 4; ++j) { v0[j] = sigmoidf_(v0[j] * rsc); v1[j] = sigmoidf_(v1[j] * rsc); } }
                    u32x4 w; w.x = cvt_pk_bf16(v0[0], v0[1]); w.y = cvt_pk_bf16(v0[2], v0[3]); w.z = cvt_pk_bf16(v1[0], v1[1]); w.w = cvt_pk_bf16(v1[2], v1[3]);
                    *(u32x4*)(rowp + bj * bjs) = w; } }
    }
};
struct EpiGroup {
    static constexpr bool PERM = true;
    bf16* O; float rmul;
    __device__ __forceinline__ void operator()(const f32x4 (&acc)[2][2][4][2], const Unit& u, int wr, int wc, int fr, int fq) const {
        bf16* const base = O + (size_t)(2 * u.pn) * UGS + (size_t)(u.pm * BM + wr * 64 + fr) * 128 + wc * 32 + 8 * fq;
#pragma unroll
        for (int ai = 0; ai < 2; ++ai)
#pragma unroll
            for (int m = 0; m < 4; ++m)
#pragma unroll
                for (int bj = 0; bj < 2; ++bj) { const f32x4 v0 = acc[ai][bj][m][0] * rmul, v1 = acc[ai][bj][m][1] * rmul;
                    u32x4 w; w.x = cvt_pk_bf16(v0[0], v0[1]); w.y = cvt_pk_bf16(v0[2], v0[3]); w.z = cvt_pk_bf16(v1[0], v1[1]); w.w = cvt_pk_bf16(v1[2], v1[3]);
                    *(u32x4*)(base + (size_t)bj * UGS + (ai * HALF + m * 16) * 128) = w; }
    }
};
struct EpiResBf16 {
    static constexpr bool PERM = true;
    bf16* H; const float* R; unsigned char* H8;
    __device__ __forceinline__ void operator()(const f32x4 (&acc)[2][2][4][2], const Unit& u, int wr, int wc, int fr, int fq) const {
        const int row0 = u.pm * BM + wr * 64 + fr, col0 = u.pn * BM + wc * 32 + 8 * fq;
#pragma unroll
        for (int ai = 0; ai < 2; ++ai) {
            f32x4 rv[4][2][2];
#pragma unroll
            for (int m = 0; m < 4; ++m)
#pragma unroll
                for (int bj = 0; bj < 2; ++bj) { const size_t ro = (size_t)(row0 + ai * HALF + m * 16) * 1024 + col0 + bj * HALF; rv[m][bj][0] = __builtin_nontemporal_load((const f32x4*)(R + ro)); rv[m][bj][1] = __builtin_nontemporal_load((const f32x4*)(R + ro + 4)); }
#pragma unroll
            for (int m = 0; m < 4; ++m) { const size_t ro = (size_t)(row0 + ai * HALF + m * 16) * 1024 + col0;
#pragma unroll
                for (int bj = 0; bj < 2; ++bj) { const f32x4 r0 = rv[m][bj][0], r1 = rv[m][bj][1];
                    const f32x4 v0 = acc[ai][bj][m][0] + r0, v1 = acc[ai][bj][m][1] + r1;
                    u32x4 w; w.x = cvt_pk_bf16(v0[0], v0[1]); w.y = cvt_pk_bf16(v0[2], v0[3]); w.z = cvt_pk_bf16(v1[0], v1[1]); w.w = cvt_pk_bf16(v1[2], v1[3]);
                    *(u32x4*)(H + ro + bj * HALF) = w;
                    u32x2 q; q.x = pk4_fp8(v0[0] * S8_H1, v0[1] * S8_H1, v0[2] * S8_H1, v0[3] * S8_H1); q.y = pk4_fp8(v1[0] * S8_H1, v1[1] * S8_H1, v1[2] * S8_H1, v1[3] * S8_H1);
                    *(u32x2*)(H8 + ro + bj * HALF) = q; } } }
    }
};
struct EpiGateUp {
    static constexpr bool PERM = true;
    unsigned char* H; const float* rowr;
    __device__ __forceinline__ void operator()(const f32x4 (&acc)[2][2][4][2], const Unit& u, int wr, int wc, int fr, int fq) const {
        const int row0 = u.pm * BM + wr * 64 + fr, col0 = u.pn * 128 + wc * 32 + 8 * fq;
        float rsv[2][4];
#pragma unroll
        for (int ai = 0; ai < 2; ++ai)
#pragma unroll
            for (int m = 0; m < 4; ++m) rsv[ai][m] = rowr[row0 + ai * HALF + m * 16] * (1.f / (S8_H1 * S8_W));
#pragma unroll
        for (int ai = 0; ai < 2; ++ai)
#pragma unroll
            for (int m = 0; m < 4; ++m) { const int row = row0 + ai * HALF + m * 16; unsigned char* rowp = H + (size_t)row * DEXP + col0; const float rr = rsv[ai][m];
                f32x4 v0, v1;
#pragma unroll
                for (int j = 0; j < 4; ++j) { v0[j] = siluf_(acc[ai][0][m][0][j] * rr) * (acc[ai][1][m][0][j] * rr) * S8_HID; v1[j] = siluf_(acc[ai][0][m][1][j] * rr) * (acc[ai][1][m][1][j] * rr) * S8_HID; }
                u32x2 w; w.x = pk4_fp8(v0[0], v0[1], v0[2], v0[3]); w.y = pk4_fp8(v1[0], v1[1], v1[2], v1[3]);
                *(u32x2*)rowp = w; }
    }
};
struct EpiDown {
    static constexpr bool PERM = true;
    unsigned char* Y; const float* roww;
    __device__ __forceinline__ void operator()(const f32x4 (&acc)[2][2][4][2], const Unit& u, int wr, int wc, int fr, int fq) const {
        const int row0 = u.pm * BM + wr * 64 + fr, col0 = u.pn * BM + wc * 32 + 8 * fq;
#pragma unroll
        for (int ai = 0; ai < 2; ++ai) {
            float rsv[4];
#pragma unroll
            for (int m = 0; m < 4; ++m) rsv[m] = roww[row0 + ai * HALF + m * 16] * (S8_Y / (S8_HID * S8_W));
#pragma unroll
            for (int m = 0; m < 4; ++m) { const int row = row0 + ai * HALF + m * 16; const float w8 = rsv[m]; unsigned char* rowp = Y + (size_t)row * 1024 + col0;
#pragma unroll
                for (int bj = 0; bj < 2; ++bj) { const f32x4 v0 = acc[ai][bj][m][0] * w8, v1 = acc[ai][bj][m][1] * w8;
                    u32x2 w; w.x = pk4_fp8(v0[0], v0[1], v0[2], v0[3]); w.y = pk4_fp8(v1[0], v1[1], v1[2], v1[3]);
                    *(u32x2*)(rowp + bj * HALF) = w; } } }
    }
};
}

struct Args { const float* in[22]; float* out; unsigned char* ws; int ph_lo, ph_hi; };
struct Frame {
    LAS unsigned char* lds; int tid, lane, wave, G, wg;
    const float* const* in; float* out; unsigned char* ws;
};
#define WSP(T_, off) ((T_*)(F.ws + (off)))

__device__ __forceinline__ void transpose_item(const float* W, int ldw, int k0, int nsrc0, bf16* WT, int Kdst, int ndst0, LAS float* scr, int lane, const float* ksc = nullptr, unsigned char* f8 = nullptr) {
    float tv[32];
#pragma unroll
    for (int i = 0; i < 32; ++i) tv[i] = __builtin_nontemporal_load(&W[(size_t)(k0 + 2 * i + (lane >> 5)) * ldw + nsrc0 + (lane & 31)]);
    if (ksc) {
#pragma unroll
        for (int i = 0; i < 32; ++i) tv[i] *= ksc[k0 + 2 * i + (lane >> 5)]; }
#pragma unroll
    for (int i = 0; i < 32; ++i) scr[(2 * i + (lane >> 5)) * 33 + (lane & 31)] = tv[i];
    LDS_WAIT();
    const int c = lane & 7;
#pragma unroll
    for (int j = 0; j < 4; ++j) { const int n = (lane >> 3) + 8 * j; const LAS float* s = scr + (8 * c) * 33 + n;
        if (f8) { u32x2 o; o.x = pk4_fp8(s[0 * 33] * S8_W, s[1 * 33] * S8_W, s[2 * 33] * S8_W, s[3 * 33] * S8_W); o.y = pk4_fp8(s[4 * 33] * S8_W, s[5 * 33] * S8_W, s[6 * 33] * S8_W, s[7 * 33] * S8_W);
            *(u32x2*)(f8 + (size_t)(ndst0 + n) * Kdst + k0 + 8 * c) = o; }
        else { u32x4 o; o.x = pk2(s[0 * 33], s[1 * 33]); o.y = pk2(s[2 * 33], s[3 * 33]); o.z = pk2(s[4 * 33], s[5 * 33]); o.w = pk2(s[6 * 33], s[7 * 33]);
            *(u32x4*)(WT + (size_t)(ndst0 + n) * Kdst + k0 + 8 * c) = o; } }
    LDS_WAIT();
}
__device__ __forceinline__ void p0_weights(Frame& F) {
    LAS float* scr = (LAS float*)(F.lds + F.wave * 9216);
    const int gw = F.wg * NWAVES + F.wave, NGW = F.G * NWAVES;
    constexpr int J0 = 1024, J1 = J0 + 768, J2 = J1 + 512, J3 = J2 + 512, J4 = J3 + 128, J5 = J4 + 8192, J6 = J5 + 8192, J7 = J6 + 8192;
    for (int it = gw; it < J7; it += NGW) {
        if (it < J0) { const int r = it, kb = r / 64, nb = r % 64; const bool q8 = 32 * nb >= 1024;
            transpose_item(F.in[3], INC, 64 * kb, 32 * nb, WSP(bf16, WS_WIN), 1024, 32 * nb, scr, F.lane, nullptr, q8 ? WSP(unsigned char, WS_WIN8) : nullptr); }
        else if (it < J1) { const int r = it - J0, kb = r / 48, nb = r % 48; const bool q8 = 2048 + 32 * nb >= 3072;
            transpose_item(F.in[3], INC, 64 * kb, 2056 + 32 * nb, WSP(bf16, WS_WIN), 1024, 2048 + 32 * nb, scr, F.lane, nullptr, q8 ? WSP(unsigned char, WS_WIN8) : nullptr); }
        else if (it < J2) { const int r = it - J1, kb = r / 32, nb = r % 32; transpose_item(F.in[8], 1024, 64 * kb, 32 * nb, WSP(bf16, WS_WOUT), 1024, 32 * nb, scr, F.lane); }
        else if (it < J3) { const int r = it - J2, kb = r / 32, nb = r % 32; transpose_item(F.in[18], 1024, 64 * kb, 32 * nb, nullptr, 1024, 32 * nb, scr, F.lane, F.in[17], WSP(unsigned char, WS_WPG)); }
        else if (it < J4) { const int r = it - J3, kb = r / 32, nb = r % 32; transpose_item(F.in[19], 1024, 64 * kb, 32 * nb, WSP(bf16, WS_WPP), 256, 32 * nb, scr, F.lane); }
        else if (it < J6) { const int up = it >= J5; const int r = it - (up ? J5 : J4), e = r >> 8, q = r & 255, kb = q >> 4, nb = q & 15, n0 = 32 * nb;
            transpose_item(F.in[up ? 15 : 14] + (size_t)e * 1024 * 512, 512, 64 * kb, n0, nullptr, 1024, (n0 >> 7) * 256 + (n0 & 127) + (up ? 128 : 0), scr, F.lane, F.in[9], WSP(unsigned char, WS_WGU) + (size_t)e * 1024 * 1024); }
        else { const int r = it - J6, e = r >> 8, q = r & 255, kb = q >> 5, nb = q & 31;
            transpose_item(F.in[16] + (size_t)e * 512 * 1024, 1024, 64 * kb, 32 * nb, nullptr, 512, 32 * nb, scr, F.lane, nullptr, WSP(unsigned char, WS_WD) + (size_t)e * 1024 * 512); }
    }
    const int gt = F.wg * NTHR + F.tid, NGT = F.G * NTHR;
    for (int i = gt; i < 48 * 1024; i += NGT) { const int j = i >> 10, k = i & 1023;
        const float w = (j < 36) ? F.in[9][k] * ((j < 4) ? F.in[10][k * 4 + j] : F.in[12][k * 32 + (j - 4)]) : 0.f;
        const unsigned hi = f2bf(w); const unsigned lo = f2bf(w - bf2f(hi));
        WSP(bf16, MS_WRH)[i] = (bf16)hi; WSP(bf16, MS_WRL)[i] = (bf16)lo; }
    for (int i = gt; i < T * 256 / 8; i += NGT) { const f32x4 a = __builtin_nontemporal_load((const f32x4*)F.in[1] + 2 * i), b = __builtin_nontemporal_load((const f32x4*)F.in[1] + 2 * i + 1);
        u32x4 o; o.x = pk2(a[0], a[1]); o.y = pk2(a[2], a[3]); o.z = pk2(b[0], b[1]); o.w = pk2(b[2], b[3]); WSP(u32x4, WS_PB)[i] = o; }
}
__device__ __forceinline__ void p0_rows(Frame& F) {
    LAS float* wg8 = (LAS float*)(F.lds + 73728);
    __syncthreads();
    { float t[16];
#pragma unroll
      for (int q = 0; q < 16; ++q) { const int i = F.tid + NTHR * q, k = i >> 3, j = i & 7; t[q] = F.in[3][(size_t)k * INC + 2048 + j]; }
#pragma unroll
      for (int q = 0; q < 16; ++q) { const int i = F.tid + NTHR * q, k = i >> 3, j = i & 7; wg8[j * 1024 + k] = t[q]; } }
    __syncthreads();
    const int gw = F.wg * NWAVES + F.wave, NGW = F.G * NWAVES;
    f32x4 g[4];
#pragma unroll
    for (int j = 0; j < 4; ++j) g[j] = ((const f32x4*)F.in[2])[F.lane + 64 * j];
    const float bg = F.in[4][F.lane >> 3];
    f32x4 nx[4];
#pragma unroll
    for (int j = 0; j < 4; ++j) nx[j] = __builtin_nontemporal_load((const f32x4*)(F.in[0] + (size_t)gw * D) + F.lane + 64 * j);
    for (int m = gw; m < T; m += NGW) {
        f32x4 v[4]; float s = 0.f;
#pragma unroll
        for (int j = 0; j < 4; ++j) v[j] = nx[j];
        if (m + NGW < T) {
#pragma unroll
            for (int j = 0; j < 4; ++j) nx[j] = __builtin_nontemporal_load((const f32x4*)(F.in[0] + (size_t)(m + NGW) * D) + F.lane + 64 * j); }
#pragma unroll
        for (int j = 0; j < 4; ++j) s += (v[j].x * v[j].x + v[j].y * v[j].y) + (v[j].z * v[j].z + v[j].w * v[j].w);
        const float r = rsqrtf(wave_sum(s) * (1.f / D) + EPS);
#pragma unroll
        for (int j = 0; j < 4; ++j) v[j] = v[j] * r * g[j];
        u32x2* o8 = (u32x2*)(WSP(bf16, WS_A64) + (size_t)m * D) + F.lane;
#pragma unroll
        for (int j = 0; j < 4; ++j) { u32x2 o; o.x = pk2(v[j].x, v[j].y); o.y = pk2(v[j].z, v[j].w); o8[64 * j] = o; }
        { unsigned* q8 = (unsigned*)((unsigned char*)F.out + (size_t)m * D) + F.lane;
#pragma unroll
          for (int j = 0; j < 4; ++j) q8[64 * j] = pk4_fp8(v[j].x * S8_H1, v[j].y * S8_H1, v[j].z * S8_H1, v[j].w * S8_H1); }
        float ga[8];
#pragma unroll
        for (int gi = 0; gi < 8; ++gi) { float a = 0.f;
#pragma unroll
            for (int j = 0; j < 4; ++j) { const f32x4 w = *(const LAS f32x4*)(wg8 + gi * 1024 + 4 * F.lane + 256 * j); a += (v[j].x * w.x + v[j].y * w.y) + (v[j].z * w.z + v[j].w * w.w); }
            ga[gi] = a; }
        float tot = 0.f;
#pragma unroll
        for (int gi = 0; gi < 8; ++gi) { const float t = wave_sum(ga[gi]); tot = ((F.lane >> 3) == gi) ? t : tot; }
        if ((F.lane & 7) == 0) WSP(float, MS_GATES)[(size_t)m * 8 + (F.lane >> 3)] = tot + bg;
    }
}

__device__ __forceinline__ void p4_router(Frame& F) {
    constexpr int RB = 528;
    LAS unsigned char* Bh = F.lds; LAS unsigned char* Bl = F.lds + 48 * RB; LAS unsigned char* Aw = F.lds + 51200 + F.wave * (16 * RB);
    LAS int* hist = (LAS int*)(F.lds + RING_BYTES);
    LAS float* lg = (LAS float*)Aw;
    if (F.tid < 32) hist[F.tid] = 0;
    const int lane = F.lane, fr = lane & 15, fq = lane >> 4;
    const int m0 = F.wg * 128 + F.wave * 16;
    const bf16* HB = WSP(bf16, WS_HB) + (size_t)m0 * D; const bf16* WH = WSP(bf16, MS_WRH); const bf16* WL = WSP(bf16, MS_WRL);
    u32x4 ra[8], rh[3], rl[3];
#define RT_LOAD(ch) do { _Pragma("unroll") for (int i = 0; i < 8; ++i) { const int p_ = lane + 64 * i; ra[i] = *(const u32x4*)(HB + (size_t)(p_ >> 5) * D + 256 * (ch) + (p_ & 31) * 8); } \
        _Pragma("unroll") for (int i = 0; i < 3; ++i) { const int p_ = F.tid + NTHR * i; rh[i] = *(const u32x4*)(WH + (p_ >> 5) * 1024 + 256 * (ch) + (p_ & 31) * 8); rl[i] = *(const u32x4*)(WL + (p_ >> 5) * 1024 + 256 * (ch) + (p_ & 31) * 8); } } while (0)
#define RT_STORE() do { _Pragma("unroll") for (int i = 0; i < 8; ++i) { const int p_ = lane + 64 * i; *(LAS u32x4*)(Aw + (p_ >> 5) * RB + (p_ & 31) * 16) = ra[i]; } \
        _Pragma("unroll") for (int i = 0; i < 3; ++i) { const int p_ = F.tid + NTHR * i; *(LAS u32x4*)(Bh + (p_ >> 5) * RB + (p_ & 31) * 16) = rh[i]; *(LAS u32x4*)(Bl + (p_ >> 5) * RB + (p_ & 31) * 16) = rl[i]; } } while (0)
    RT_LOAD(0);
    f32x4 acc[3]; float ss = 0.f;
#pragma unroll
    for (int n = 0; n < 3; ++n) acc[n] = (f32x4){0.f, 0.f, 0.f, 0.f};
    for (int ch = 0; ch < 4; ++ch) {
        __syncthreads();
        RT_STORE();
        __syncthreads();
        if (ch + 1 < 4) RT_LOAD(ch + 1);
#pragma unroll
        for (int kk = 0; kk < 8; ++kk) { const bf16x8 a = *(const LAS bf16x8*)(Aw + fr * RB + (32 * kk + 8 * fq) * 2); const u32x4 aw = __builtin_bit_cast(u32x4, a);
#pragma unroll
            for (int i = 0; i < 4; ++i) { const float x = bflo(aw[i]), y = bfhi(aw[i]); ss += x * x + y * y; }
#pragma unroll
            for (int n = 0; n < 3; ++n) { const bf16x8 wh = *(const LAS bf16x8*)(Bh + (16 * n + fr) * RB + (32 * kk + 8 * fq) * 2), wl = *(const LAS bf16x8*)(Bl + (16 * n + fr) * RB + (32 * kk + 8 * fq) * 2);
                acc[n] = MFMA16(a, wh, acc[n]); acc[n] = MFMA16(a, wl, acc[n]); } }
    }
#undef RT_LOAD
#undef RT_STORE
    ss += __shfl_xor(ss, 16); ss += __shfl_xor(ss, 32);
    const float rr = rsqrtf(ss * (1.f / D) + EPS);
    if (fq == 0) WSP(float, MS_R1)[m0 + fr] = rr;
    __syncthreads();
#pragma unroll
    for (int r = 0; r < 4; ++r) { const float rrow = __shfl(rr, 4 * fq + r);
#pragma unroll
        for (int n = 0; n < 3; ++n) { const int col = 16 * n + fr; const float bias = (col < 4) ? F.in[11][col] : ((col < 36) ? F.in[13][col - 4] : 0.f);
            lg[(4 * fq + r) * 48 + col] = acc[n][r] * rrow + bias; } }
    LDS_WAIT();
    if (lane < 16) {
        const int m = m0 + lane; const LAS float* row = lg + lane * 48;
        float gl[4];
#pragma unroll
        for (int q = 0; q < 4; ++q) gl[q] = row[q];
        int gs = 0; float gm = gl[0];
#pragma unroll
        for (int q = 1; q < 4; ++q) if (gl[q] > gm) { gm = gl[q]; gs = q; }
        float den = 0.f;
#pragma unroll
        for (int q = 0; q < 4; ++q) den += __expf(gl[q] - gm);
        const float pg = 1.f / den;
        float el[8];
#pragma unroll
        for (int q = 0; q < 8; ++q) el[q] = row[4 + gs * 8 + q];
        int i0 = 0; float v0 = el[0];
#pragma unroll
        for (int q = 1; q < 8; ++q) if (el[q] > v0) { v0 = el[q]; i0 = q; }
        int i1 = -1; float v1 = -3.0e38f;
#pragma unroll
        for (int q = 0; q < 8; ++q) if (q != i0 && el[q] > v1) { v1 = el[q]; i1 = q; }
        const float e1 = __expf(v1 - v0), w0 = pg / (1.f + e1), w1 = pg * e1 / (1.f + e1);
        const int ea = gs * 8 + i0, eb = gs * 8 + i1;
        WSP(int, MS_RE)[2 * m] = ea; WSP(int, MS_RE)[2 * m + 1] = eb;
        WSP(float, MS_RW)[2 * m] = w0; WSP(float, MS_RW)[2 * m + 1] = w1;
        atomicAdd((int*)&hist[ea], 1); atomicAdd((int*)&hist[eb], 1);
    }
    __syncthreads();
    if (F.tid < 32) WSP(int, MS_CNT)[F.wg * 32 + F.tid] = hist[F.tid];
}

__device__ __forceinline__ void p5_scatter(Frame& F) {
    LAS int* base = (LAS int*)(F.lds);
    LAS int* tot = base + 32;
    LAS int* poff = base + 64;
    LAS int* arr = base + 128;
    LAS int* dst = base + 384;
    const int* cnt = WSP(int, MS_CNT);
    if (F.tid < 64) base[F.tid] = 0;
    __syncthreads();
    { const int e = F.tid & 31, part = F.tid >> 5; int t = 0, b = 0;
#pragma unroll
      for (int j = 0; j < 16; ++j) { const int w = part * 16 + j; const int c = cnt[w * 32 + e]; t += c; b += (w < F.wg) ? c : 0; }
      atomicAdd((int*)&tot[e], t); atomicAdd((int*)&base[e], b); }
    __syncthreads();
    if (F.tid == 0) { int o = 0; for (int e = 0; e < 32; ++e) { poff[e] = o; o += (tot[e] + 255) & ~255; } poff[32] = o; }
    __syncthreads();
    if (F.tid < 32) base[F.tid] += poff[F.tid];
    if (F.tid < 256) arr[F.tid] = WSP(int, MS_RE)[F.wg * 256 + F.tid];
    __syncthreads();
    if (F.tid < 256) { const int e = arr[F.tid]; int rk = 0; for (int j = 0; j < F.tid; ++j) rk += (arr[j] == e) ? 1 : 0;
        const int d = base[e] + rk; dst[F.tid] = d; WSP(int, MS_POS)[F.wg * 256 + F.tid] = d; WSP(float, MS_ROWW)[d] = WSP(float, MS_RW)[F.wg * 256 + F.tid];
        WSP(float, MS_ROWR)[d] = WSP(float, MS_R1)[F.wg * 128 + (F.tid >> 1)]; WSP(int, MS_ROWTOK)[d] = F.wg * 128 + (F.tid >> 1); }
    __syncthreads();
    if (F.wg < 32) { const int e = F.wg, r0 = poff[e] + tot[e], r1 = poff[e + 1];
        for (int r = r0 + F.tid; r < r1; r += NTHR) { WSP(float, MS_ROWW)[r] = 0.f; WSP(float, MS_ROWR)[r] = 0.f; WSP(int, MS_ROWTOK)[r] = 0; } }
    if (F.wg == 0) { int* pane = WSP(int, MS_PANE); const int np = poff[32] >> 8; if (F.tid == 0) pane[0] = np;
        for (int p = F.tid; p < np; p += NTHR) { int e = 0; for (int q = 1; q < 32; ++q) e += (p * 256 >= poff[q]) ? 1 : 0; pane[1 + p] = e; } }
    __syncthreads();
}

template <bool MOE>
__device__ __forceinline__ void p8_rows(Frame& F) {
    const int gw = F.wg * NWAVES + F.wave, NGW = F.G * NWAVES;
    bf16* HB = WSP(bf16, WS_HB); const int* POS = WSP(int, MS_POS); const unsigned char* Y = WSP(unsigned char, WS_XIN);
    u32x2 nh[4]; unsigned na[4], nb[4]; int np0 = 0, np1 = 0;
    { const int m = gw;
      if (MOE) { np0 = POS[2 * m]; np1 = POS[2 * m + 1]; }
#pragma unroll
      for (int j = 0; j < 4; ++j) { nh[j] = ((const u32x2*)(HB + (size_t)m * D) + F.lane)[64 * j];
          if (MOE) { na[j] = ((const unsigned*)(Y + (size_t)np0 * D) + F.lane)[64 * j]; nb[j] = ((const unsigned*)(Y + (size_t)np1 * D) + F.lane)[64 * j]; } }
      if (MOE && m + NGW < T) { np0 = POS[2 * (m + NGW)]; np1 = POS[2 * (m + NGW) + 1]; } }
    for (int m = gw; m < T; m += NGW) {
        u32x2 ch[4]; unsigned ca[4], cb[4];
#pragma unroll
        for (int j = 0; j < 4; ++j) { ch[j] = nh[j]; ca[j] = na[j]; cb[j] = nb[j]; }
        const int mn = m + NGW;
        if (mn < T) {
#pragma unroll
            for (int j = 0; j < 4; ++j) { nh[j] = ((const u32x2*)(HB + (size_t)mn * D) + F.lane)[64 * j];
                if (MOE) { na[j] = ((const unsigned*)(Y + (size_t)np0 * D) + F.lane)[64 * j]; nb[j] = ((const unsigned*)(Y + (size_t)np1 * D) + F.lane)[64 * j]; } }
            if (MOE && mn + NGW < T) { np0 = POS[2 * (mn + NGW)]; np1 = POS[2 * (mn + NGW) + 1]; } }
        f32x4 v[4]; float s = 0.f;
#pragma unroll
        for (int j = 0; j < 4; ++j) v[j] = (f32x4){bflo(ch[j].x), bfhi(ch[j].x), bflo(ch[j].y), bfhi(ch[j].y)};
        if (MOE) {
            u32x2* xr = (u32x2*)(HB + (size_t)m * D) + F.lane;
#pragma unroll
            for (int j = 0; j < 4; ++j) { const f32x2 a0 = __builtin_amdgcn_cvt_pk_f32_fp8((int)ca[j], false), a1 = __builtin_amdgcn_cvt_pk_f32_fp8((int)ca[j], true);
                const f32x2 b0 = __builtin_amdgcn_cvt_pk_f32_fp8((int)cb[j], false), b1 = __builtin_amdgcn_cvt_pk_f32_fp8((int)cb[j], true);
                v[j].x += (a0.x + b0.x) * (1.f / S8_Y); v[j].y += (a0.y + b0.y) * (1.f / S8_Y); v[j].z += (a1.x + b1.x) * (1.f / S8_Y); v[j].w += (a1.y + b1.y) * (1.f / S8_Y); }
#pragma unroll
            for (int j = 0; j < 4; ++j) { u32x2 o; o.x = pk2(v[j].x, v[j].y); o.y = pk2(v[j].z, v[j].w); xr[64 * j] = o; }
        }
        { unsigned* q8 = (unsigned*)(WSP(unsigned char, WS_H2Q) + (size_t)m * D) + F.lane;
#pragma unroll
          for (int j = 0; j < 4; ++j) q8[64 * j] = pk4_fp8(v[j].x * S8_H1, v[j].y * S8_H1, v[j].z * S8_H1, v[j].w * S8_H1); }
#pragma unroll
        for (int j = 0; j < 4; ++j) s += (v[j].x * v[j].x + v[j].y * v[j].y) + (v[j].z * v[j].z + v[j].w * v[j].w);
        const float r = rsqrtf(wave_sum(s) * (1.f / D) + EPS);
        if (F.lane == 0) WSP(float, MS_R2)[m] = r;
    }
}

__device__ __forceinline__ void p10_rows(Frame& F) {
    const int gw = F.wg * NWAVES + F.wave, NGW = F.G * NWAVES;
    f32x4 gp[4], gf[4];
#pragma unroll
    for (int j = 0; j < 4; ++j) { gp[j] = ((const f32x4*)F.in[20])[F.lane + 64 * j]; gf[j] = ((const f32x4*)F.in[21])[F.lane + 64 * j]; }
    const bf16* HB = WSP(bf16, WS_HB); const bf16* PB = WSP(bf16, WS_A64); const bf16* GB = WSP(bf16, WS_G);
    u32x2 nh[4], np[4], ng[4];
#pragma unroll
    for (int j = 0; j < 4; ++j) { nh[j] = ((const u32x2*)(HB + (size_t)gw * D) + F.lane)[64 * j]; np[j] = ((const u32x2*)(PB + (size_t)gw * D) + F.lane)[64 * j]; ng[j] = ((const u32x2*)(GB + (size_t)gw * D) + F.lane)[64 * j]; }
    for (int m = gw; m < T; m += NGW) {
        f32x4 h[4], pv[4], gv[4]; float s = 0.f;
#pragma unroll
        for (int j = 0; j < 4; ++j) { const u32x2 hh = nh[j], a = np[j], b = ng[j]; h[j] = (f32x4){bflo(hh.x), bfhi(hh.x), bflo(hh.y), bfhi(hh.y)};
            pv[j] = (f32x4){bflo(a.x), bfhi(a.x), bflo(a.y), bfhi(a.y)}; gv[j] = (f32x4){bflo(b.x), bfhi(b.x), bflo(b.y), bfhi(b.y)}; }
        const int mn = m + NGW;
        if (mn < T) {
#pragma unroll
            for (int j = 0; j < 4; ++j) { nh[j] = ((const u32x2*)(HB + (size_t)mn * D) + F.lane)[64 * j]; np[j] = ((const u32x2*)(PB + (size_t)mn * D) + F.lane)[64 * j]; ng[j] = ((const u32x2*)(GB + (size_t)mn * D) + F.lane)[64 * j]; } }
#pragma unroll
        for (int j = 0; j < 4; ++j) s += (pv[j].x * pv[j].x + pv[j].y * pv[j].y) + (pv[j].z * pv[j].z + pv[j].w * pv[j].w);
        const float r = rsqrtf(wave_sum(s) * (1.f / D) + EPS);
        float s2 = 0.f;
#pragma unroll
        for (int j = 0; j < 4; ++j) { h[j] = h[j] + gv[j] * (pv[j] * r * gp[j]); s2 += (h[j].x * h[j].x + h[j].y * h[j].y) + (h[j].z * h[j].z + h[j].w * h[j].w); }
        const float r2 = rsqrtf(wave_sum(s2) * (1.f / D) + EPS);
        f32x4* xr = (f32x4*)(F.out + (size_t)m * D) + F.lane;
#pragma unroll
        for (int j = 0; j < 4; ++j) __builtin_nontemporal_store(h[j] * r2 * gf[j], &xr[64 * j]);
    }
}

constexpr int ML_RAWK = 0, ML_RAWQ = 17408, ML_KT = 34816, ML_VT = 53248, ML_QIMG = 71680, ML_KIMG = 89088, ML_SM = 106496;
constexpr int KT_LD = 72, IMG_LD = 136;

__device__ __forceinline__ float wave_scan_add(float v, int lane) {
#pragma unroll
    for (int o = 1; o < 64; o <<= 1) { const float t = __shfl_up(v, o); v += (lane >= o) ? t : 0.f; }
    return v;
}
__device__ __forceinline__ float wave_scan_max(float v, int lane) {
#pragma unroll
    for (int o = 1; o < 64; o <<= 1) { const float t = __shfl_up(v, o); v = (lane >= o) ? fmaxf(v, t) : v; }
    return v;
}
__device__ __forceinline__ void ml_conv2x8(const LAS bf16* raw, int s, int d0, const LAS float* wbase, float scale, float (&o0)[8], float (&o1)[8]) {
    u32x4 r[5];
#pragma unroll
    for (int j = 0; j < 5; ++j) r[j] = *(const LAS u32x4*)(raw + (s + j) * 128 + d0);
    float a0[8], a1[8];
#pragma unroll
    for (int i = 0; i < 8; ++i) { a0[i] = 0.f; a1[i] = 0.f; }
#pragma unroll
    for (int j = 0; j < 4; ++j) { const f32x4 wa = *(const LAS f32x4*)(wbase + j * 128), wb = *(const LAS f32x4*)(wbase + j * 128 + 4);
        const float w[8] = {wa[0], wa[1], wa[2], wa[3], wb[0], wb[1], wb[2], wb[3]};
#pragma unroll
        for (int i = 0; i < 4; ++i) { const unsigned x0 = r[j][i], x1 = r[j + 1][i];
            a0[2 * i] += bflo(x0) * w[2 * i]; a0[2 * i + 1] += bfhi(x0) * w[2 * i + 1]; a1[2 * i] += bflo(x1) * w[2 * i]; a1[2 * i + 1] += bfhi(x1) * w[2 * i + 1]; } }
#pragma unroll
    for (int i = 0; i < 8; ++i) { o0[i] = siluf_(a0[i]) * scale; o1[i] = siluf_(a1[i]) * scale; }
}
constexpr int AT_LDB = 144;
__device__ __forceinline__ s16x4 lds_tr_read(unsigned addr) { s16x4 r; asm volatile("ds_read_b64_tr_b16 %0, %1" : "=&v"(r) : "v"(addr) : "memory"); return r; }
__device__ __forceinline__ void p2d_attention(Frame& F, int w0, int nw) {
    LAS unsigned char* vl = F.lds + F.wave * 15360;
    LAS unsigned char* kl = vl + 5120; LAS unsigned char* ql = vl + 10240;
    const bf16* U = WSP(bf16, WS_U); bf16* MX = WSP(bf16, WS_A64);
    const int lane = F.lane, fr = lane & 15, fq = lane >> 4;
    const int gw = F.wg * nw + (F.wave - w0), NGW = F.G * nw;
    constexpr float SCL = 0.125f * 1.4426950408889634f;
    const unsigned tra = (unsigned)(size_t)(vl + (4 * fq + (fr >> 2)) * AT_LDB + (fr & 3) * 8);
    for (int task = gw; task < 8192; task += NGW) {
        const int bh = task >> 8, tt = task & 255, b = bh >> 3, h = bh & 7, t0 = tt * 32;
        const size_t hb = (size_t)(h >> 1) * UGS + (size_t)b * SEQ * 128 + (h & 1) * 64;
        const bf16* uq = U + GSQ * UGS + hb; const bf16* uk = U + GSK * UGS + hb; const bf16* uv = U + GSV * UGS + hb;
        bf16x8 qf[2][2];
        { u32x4 qc[4];
#pragma unroll
          for (int i = 0; i < 4; ++i) { const int ch = lane + 64 * i; qc[i] = *(const u32x4*)(uq + (size_t)(t0 + (ch >> 3)) * 128 + (ch & 7) * 8); }
#pragma unroll
          for (int i = 0; i < 4; ++i) { const int ch = lane + 64 * i; *(LAS u32x4*)(ql + (ch >> 3) * AT_LDB + (ch & 7) * 16) = qc[i]; }
          LDS_WAIT();
#pragma unroll
          for (int u = 0; u < 2; ++u)
#pragma unroll
              for (int kk = 0; kk < 2; ++kk) qf[u][kk] = *(const LAS bf16x8*)(ql + (16 * u + fr) * AT_LDB + (32 * kk + 8 * fq) * 2); }
        f32x4 ao[2][4];
#pragma unroll
        for (int u = 0; u < 2; ++u)
#pragma unroll
            for (int n = 0; n < 4; ++n) ao[u][n] = (f32x4){0.f, 0.f, 0.f, 0.f};
        float carry[2] = {0.f, 0.f};
        u32x4 vc[4], kc[4];
#pragma unroll
        for (int i = 0; i < 4; ++i) { const int ch = lane + 64 * i; kc[i] = *(const u32x4*)(uk + (size_t)(t0 + (ch >> 3)) * 128 + (ch & 7) * 8); vc[i] = *(const u32x4*)(uv + (size_t)(t0 + (ch >> 3)) * 128 + (ch & 7) * 8); }
        for (int s0 = t0; s0 >= 0; s0 -= 32) {
            bf16x8 kf[2][2];
#pragma unroll
            for (int i = 0; i < 4; ++i) { const int ch = lane + 64 * i; *(LAS u32x4*)(kl + (ch >> 3) * AT_LDB + (ch & 7) * 16) = kc[i]; }
#pragma unroll
            for (int i = 0; i < 4; ++i) { const int ch = lane + 64 * i; *(LAS u32x4*)(vl + (ch >> 3) * AT_LDB + (ch & 7) * 16) = vc[i]; }
            LDS_WAIT();
#pragma unroll
            for (int ms = 0; ms < 2; ++ms)
#pragma unroll
                for (int kk = 0; kk < 2; ++kk) kf[ms][kk] = *(const LAS bf16x8*)(kl + (16 * ms + fr) * AT_LDB + (32 * kk + 8 * fq) * 2);
            bf16x8 pa[2];
#pragma unroll
            for (int u = 0; u < 2; ++u) {
                const int t = t0 + 16 * u + fr;
                f32x4 z[2];
#pragma unroll
                for (int ms = 0; ms < 2; ++ms) { z[ms] = (f32x4){0.f, 0.f, 0.f, 0.f}; z[ms] = MFMA16(kf[ms][0], qf[u][0], z[ms]); z[ms] = MFMA16(kf[ms][1], qf[u][1], z[ms]); }
                float sp[2][4], g[2];
#pragma unroll
                for (int ms = 0; ms < 2; ++ms) { g[ms] = 0.f;
#pragma unroll
                    for (int r = 0; r < 4; ++r) { const int s = s0 + 16 * ms + 4 * fq + r; const float z2 = z[ms][r] * SCL; z[ms][r] = z2;
                        const float l = __builtin_amdgcn_logf(1.f + __builtin_amdgcn_exp2f(-fabsf(z2))); const float v = (s < t) ? fmaxf(z2, 0.f) + l : 0.f; sp[ms][r] = v; g[ms] += v; } }
                float S0 = g[1], S1 = 0.f, tot = g[0] + g[1];
#pragma unroll
                for (int x = 1; x < 4; ++x) { const float o0 = __shfl_xor(g[0], 16 * x), o1 = __shfl_xor(g[1], 16 * x); const bool later = (fq ^ x) > fq;
                    S0 += o1 + (later ? o0 : 0.f); S1 += later ? o1 : 0.f; tot += o0 + o1; }
                float p[2][4];
#pragma unroll
                for (int ms = 0; ms < 2; ++ms) { float cs = carry[u] + (ms == 0 ? S0 : S1);
#pragma unroll
                    for (int r = 3; r >= 0; --r) { cs += sp[ms][r]; const int s = s0 + 16 * ms + 4 * fq + r; p[ms][r] = (s < t) ? __builtin_amdgcn_exp2f(z[ms][r] - cs) : 0.f; } }
                carry[u] += tot;
                u32x4 pw; pw.x = pk2(p[0][0], p[0][1]); pw.y = pk2(p[0][2], p[0][3]); pw.z = pk2(p[1][0], p[1][1]); pw.w = pk2(p[1][2], p[1][3]);
                pa[u] = __builtin_bit_cast(bf16x8, pw);
            }
            const bool more = (s0 >= 32) && !__all(carry[0] > 64.f && carry[1] > 64.f);
            if (more) {
#pragma unroll
                for (int i = 0; i < 4; ++i) { const int ch = lane + 64 * i; kc[i] = *(const u32x4*)(uk + (size_t)(s0 - 32 + (ch >> 3)) * 128 + (ch & 7) * 8); vc[i] = *(const u32x4*)(uv + (size_t)(s0 - 32 + (ch >> 3)) * 128 + (ch & 7) * 8); } }
            s16x4 vlo[4], vhi[4];
#pragma unroll
            for (int n = 0; n < 4; ++n) { vlo[n] = lds_tr_read(tra + n * 32); vhi[n] = lds_tr_read(tra + n * 32 + 16 * AT_LDB); }
            LDS_WAIT(); __builtin_amdgcn_sched_barrier(0);
#pragma unroll
            for (int n = 0; n < 4; ++n) { bf16x8 vb; vb[0] = vlo[n][0]; vb[1] = vlo[n][1]; vb[2] = vlo[n][2]; vb[3] = vlo[n][3]; vb[4] = vhi[n][0]; vb[5] = vhi[n][1]; vb[6] = vhi[n][2]; vb[7] = vhi[n][3];
                ao[0][n] = MFMA16(vb, pa[0], ao[0][n]); ao[1][n] = MFMA16(vb, pa[1], ao[1][n]); }
            if (!more) break;
        }
#pragma unroll
        for (int u = 0; u < 2; ++u)
#pragma unroll
            for (int n = 0; n < 4; ++n) { u32x2 o; o.x = pk2(ao[u][n][0], ao[u][n][1]); o.y = pk2(ao[u][n][2], ao[u][n][3]);
                *(u32x2*)(MX + ((size_t)b * SEQ + t0 + 16 * u + fr) * D + 512 + h * 64 + 16 * n + 4 * fq) = o; }
    }
}

constexpr int NSC = 16, SCR = 512;
constexpr int FM_RAWQ = 0, FM_RAWK = 17408, FM_QI = 34816, FM_KI = 52224, FM_KE = 69632, FM_VI = 87040, FM_CT = 104448, FM_SM = 139264;
constexpr int IB = 272;
struct FmRegs { u32x4 k0, k1, q0, q1, v0, v1, hh, o0, o1; f32x4 gs; float ml, bl; };
template <bool WITH_Q, int HT0 = 0, bool HALO = true>
__device__ __forceinline__ void fm_load(Frame& F, FmRegs& R, int b, int h, int c  ) {
    const bf16* U = WSP(bf16, WS_U); const float* gates = WSP(float, MS_GATES);
    const size_t rb = ((size_t)b * SEQ + c * 64) * 128;
    const bf16* uq = U + (GQ + h) * UGS + rb; const bf16* uk = U + (GK + h) * UGS + rb; const bf16* uv = U + (GV + h) * UGS + rb;
    const int r0 = F.tid >> 4, cc = F.tid & 15;
#define FM_LD(p_) (*(const u32x4*)(p_))
    R.k0 = FM_LD(uk + r0 * 128 + cc * 8); R.k1 = FM_LD(uk + (r0 + 32) * 128 + cc * 8);
    if (WITH_Q) { R.q0 = FM_LD(uq + r0 * 128 + cc * 8); R.q1 = FM_LD(uq + (r0 + 32) * 128 + cc * 8); }
    R.v0 = FM_LD(uv + r0 * 128 + cc * 8); R.v1 = FM_LD(uv + (r0 + 32) * 128 + cc * 8);
    if (WITH_Q) { const bf16* uo = U + (GO + h) * UGS + rb; R.o0 = FM_LD(uo + r0 * 128 + cc * 8); R.o1 = FM_LD(uo + (r0 + 32) * 128 + cc * 8); }
#undef FM_LD
    R.hh = (u32x4){0u, 0u, 0u, 0u};
    { const int th = F.tid - HT0;
      if (HALO && th >= 0 && th < (WITH_Q ? 96 : 48) && c > 0) { const int isq = th >= 48, x = th - (isq ? 48 : 0), hr = x >> 4, hc = x & 15;
        R.hh = *(const u32x4*)((isq ? uq : uk) + (ptrdiff_t)(hr - 3) * 128 + hc * 8); } }
    R.gs = (f32x4){0.f, 0.f, 0.f, 0.f}; R.ml = 0.f; R.bl = 0.f;
    if (WITH_Q && F.tid < 64) { const size_t row = (size_t)b * SEQ + c * 64 + F.tid; R.gs = *(const f32x4*)(WSP(float, MS_GS) + (row * 4 + h) * 4);
        const float* chp = WSP(float, MS_CH) + ((size_t)(b * NCH + c) * 4 + h) * 2; R.ml = chp[0]; R.bl = chp[1]; }
}
template <bool WITH_Q, int HT0 = 0, bool HALO = true>
__device__ __forceinline__ void fm_store(Frame& F, const FmRegs& R) {
    const int r0 = F.tid >> 4, cc = F.tid & 15;
    *(LAS u32x4*)(F.lds + FM_RAWK + (r0 + 3) * 256 + cc * 16) = R.k0; *(LAS u32x4*)(F.lds + FM_RAWK + (r0 + 35) * 256 + cc * 16) = R.k1;
    if (WITH_Q) { *(LAS u32x4*)(F.lds + FM_RAWQ + (r0 + 3) * 256 + cc * 16) = R.q0; *(LAS u32x4*)(F.lds + FM_RAWQ + (r0 + 35) * 256 + cc * 16) = R.q1; }
    *(LAS u32x4*)(F.lds + FM_VI + r0 * IB + cc * 16) = R.v0; *(LAS u32x4*)(F.lds + FM_VI + (r0 + 32) * IB + cc * 16) = R.v1;
    { const int th = F.tid - HT0;
      if (HALO && th >= 0 && th < (WITH_Q ? 96 : 48)) { const int isq = th >= 48, x = th - (isq ? 48 : 0); *(LAS u32x4*)(F.lds + (isq ? FM_RAWQ : FM_RAWK) + (x >> 4) * 256 + (x & 15) * 16) = R.hh; } }
}
struct TrPair { s16x4 lo, hi; };
__device__ __forceinline__ TrPair fm_tr_issue(unsigned base, const int off0, const int off1) {
    TrPair p;
    asm volatile("ds_read_b64_tr_b16 %0, %1 offset:%2" : "=&v"(p.lo) : "v"(base), "i"(off0) : "memory");
    asm volatile("ds_read_b64_tr_b16 %0, %1 offset:%2" : "=&v"(p.hi) : "v"(base), "i"(off1) : "memory");
    return p;
}
__device__ __forceinline__ bf16x8 fm_tr_get(const TrPair& p) { bf16x8 r; r[0] = p.lo[0]; r[1] = p.lo[1]; r[2] = p.lo[2]; r[3] = p.lo[3]; r[4] = p.hi[0]; r[5] = p.hi[1]; r[6] = p.hi[2]; r[7] = p.hi[3]; return r; }
#define TR_WAIT() do { asm volatile("s_waitcnt lgkmcnt(0)" ::: "memory"); __builtin_amdgcn_sched_barrier(0); } while (0)
__device__ __forceinline__ void p2a_super(Frame& F) {
    LAS bf16* rawk = (LAS bf16*)(F.lds + FM_RAWK);
    LAS float* s_e = (LAS float*)(F.lds + FM_CT);
    LAS float* s_x = (LAS float*)(F.lds + FM_SM + 2304);
    LAS float* cw = (LAS float*)(F.lds + FM_SM + 2560);
    const int lane = F.lane, w = F.wave, fr = lane & 15, fq = lane >> 4;
    const int it = F.wg, bh = it >> 4, sc = it & 15, b = bh >> 2, h = bh & 3;
    const float* gates = WSP(float, MS_GATES);
    for (int i = F.tid; i < 1024; i += NTHR) { const int qk = i >> 9, j = (i >> 7) & 3, d = i & 127; cw[i] = F.in[qk ? 6 : 5][j * 512 + h * 128 + d]; }
    FmRegs R; fm_load<false>(F, R, b, h, sc * 8);
    float e_mine;
    { const size_t row = (size_t)b * SEQ + sc * SCR + 64 * w + lane; const float ip = gates[row * 8 + h], fp = gates[row * 8 + 4 + h];
      float bb = wave_scan_add(log_sigmoidf_(fp), lane);
      {
        const float blc = __shfl(bb, 63), wec = blc - bb + ip, mlc = wave_max(wec), pmc = wave_scan_max(ip - bb, lane);
        *(f32x4*)(WSP(float, MS_GS) + (row * 4 + h) * 4) = (f32x4){bb, ip, __expf(wec - mlc), pmc};
        if (lane == 0) { float* chp = WSP(float, MS_CH) + ((size_t)(b * NCH + sc * 8 + w) * 4 + h) * 2; chp[0] = mlc; chp[1] = blc; } }
      if (lane == 63) s_x[w] = bb;
      __syncthreads();
      float off = 0.f, tot = 0.f;
#pragma unroll
      for (int j = 0; j < 8; ++j) { const float t = s_x[j]; off += (j < w) ? t : 0.f; tot += t; }
      bb += off;
      const float we = tot - bb + ip; const float mw = wave_max(we);
      if (lane == 0) s_x[8 + w] = mw;
      __syncthreads();
      float ml = s_x[8];
#pragma unroll
      for (int j = 1; j < 8; ++j) ml = fmaxf(ml, s_x[8 + j]);
      e_mine = __expf(we - ml);
      s_e[64 * w + lane] = e_mine;
      if (F.tid == 0) { WSP(float, MS_MLOC)[it] = ml; WSP(float, MS_BLAST)[it] = tot; } }
    f32x4 acc[8];
#pragma unroll
    for (int n = 0; n < 8; ++n) acc[n] = (f32x4){0.f, 0.f, 0.f, 0.f};
    float dn = 0.f;
    const unsigned tra = (unsigned)(size_t)(F.lds + FM_KE + (8 * fq + (fr >> 2)) * IB + (16 * w + 4 * (fr & 3)) * 2);
    const unsigned trb = (unsigned)(size_t)(F.lds + FM_VI + (8 * fq + (fr >> 2)) * IB + (4 * (fr & 3)) * 2);
    for (int j = 0; j < 8; ++j) {
        fm_store<false>(F, R);
        __syncthreads();
        if (j + 1 < 8) fm_load<false>(F, R, b, h, sc * 8 + j + 1);
        { const int sp = F.tid >> 4, dg = F.tid & 15, s = 2 * sp, d0 = 8 * dg; float o0[8], o1[8];
          ml_conv2x8(rawk, s, d0, cw + 512 + d0, 0.08838834764831845f, o0, o1);
          const float e0 = s_e[64 * j + s], e1 = s_e[64 * j + s + 1];
          u32x4 x; x.x = pk2(o0[0] * e0, o0[1] * e0); x.y = pk2(o0[2] * e0, o0[3] * e0); x.z = pk2(o0[4] * e0, o0[5] * e0); x.w = pk2(o0[6] * e0, o0[7] * e0);
          *(LAS u32x4*)(F.lds + FM_KE + s * IB + d0 * 2) = x;
          x.x = pk2(o1[0] * e1, o1[1] * e1); x.y = pk2(o1[2] * e1, o1[3] * e1); x.z = pk2(o1[4] * e1, o1[5] * e1); x.w = pk2(o1[6] * e1, o1[7] * e1);
          *(LAS u32x4*)(F.lds + FM_KE + (s + 1) * IB + d0 * 2) = x; }
        __syncthreads();
#pragma unroll
        for (int kk = 0; kk < 2; ++kk) { const TrPair pa = fm_tr_issue(tra, 32 * kk * IB, (32 * kk + 4) * IB); TrPair pb[8];
#pragma unroll
            for (int n = 0; n < 8; ++n) pb[n] = fm_tr_issue(trb, 32 * kk * IB + 32 * n, (32 * kk + 4) * IB + 32 * n);
            TR_WAIT();
            const bf16x8 a = fm_tr_get(pa);
#pragma unroll
            for (int n = 0; n < 8; ++n) acc[n] = MFMA16(a, fm_tr_get(pb[n]), acc[n]); }
        if (F.tid < 128) { float s = 0.f;
#pragma unroll 8
            for (int r = 0; r < 64; ++r) s += bf2f(*(const LAS bf16*)(F.lds + FM_KE + r * IB + F.tid * 2));
            dn += s; }
        __syncthreads();
    }
    bf16* Cg = WSP(bf16, WS_C) + (size_t)it * 16384;
#pragma unroll
    for (int n = 0; n < 8; ++n) { u32x2 o; o.x = pk2(acc[n][0], acc[n][1]); o.y = pk2(acc[n][2], acc[n][3]);
        *(u32x2*)(Cg + (16 * n + fr) * 128 + 16 * w + 4 * fq) = o; }
    if (F.tid < 128) WSP(float, MS_DN)[it * 128 + F.tid] = dn;
}

__device__ __forceinline__ void p2c_fused(Frame& F) {
    LAS bf16* rawq = (LAS bf16*)(F.lds + FM_RAWQ); LAS bf16* rawk = (LAS bf16*)(F.lds + FM_RAWK);
    LAS float* s_b = (LAS float*)(F.lds + FM_SM); LAS float* s_li = s_b + 64; LAS float* s_e = s_b + 128; LAS float* s_mt = s_b + 192; LAS float* s_ai = s_b + 256;
    LAS float* s_n = s_b + 320;
    LAS float* s_x = s_b + 576;
    LAS float* s_ss = s_b + 592;
    LAS float* cw = (LAS float*)(F.lds + FM_SM + 3072);
    const int lane = F.lane, w = F.wave, fr = lane & 15, fq = lane >> 4;
    const int it = F.wg, bh = it >> 4, sc = it & 15, b = bh >> 2, h = bh & 3;
    const bf16* U = WSP(bf16, WS_U); bf16* MX = WSP(bf16, WS_A64);
    for (int i = F.tid; i < 1024; i += NTHR) { const int qk = i >> 9, j = (i >> 7) & 3, d = i & 127; cw[i] = F.in[qk ? 6 : 5][j * 512 + h * 128 + d]; }
    FmRegs R; fm_load<true>(F, R, b, h, sc * 8);
    float m = 0.f;
    { const int row = F.tid >> 2, pc = F.tid & 3; float acc[32], an = 0.f;
#pragma unroll
      for (int i = 0; i < 32; ++i) acc[i] = 0.f;
      const bf16* Cb = WSP(bf16, WS_C) + (size_t)(bh * NSC) * 16384 + row * 128 + pc * 32; const float* DNb = WSP(float, MS_DN) + (size_t)(bh * NSC) * 128 + (F.tid & 127);
      u32x4 nx[4]; float nd = 0.f;
      if (sc > 0) {
#pragma unroll
          for (int q = 0; q < 4; ++q) nx[q] = *(const u32x4*)(Cb + q * 8);
          nd = DNb[0]; }
      for (int p_ = 0; p_ < sc; ++p_) {
          u32x4 cv[4];
#pragma unroll
          for (int q = 0; q < 4; ++q) cv[q] = nx[q];
          const float cd = nd;
          if (p_ + 1 < sc) {
#pragma unroll
              for (int q = 0; q < 4; ++q) nx[q] = *(const u32x4*)(Cb + (size_t)(p_ + 1) * 16384 + q * 8);
              nd = DNb[(p_ + 1) * 128]; }
          const float ml = WSP(float, MS_MLOC)[bh * NSC + p_], bl = WSP(float, MS_BLAST)[bh * NSC + p_];
          const float mn = fmaxf(bl + m, ml); const float dec = __expf(bl + m - mn), scl = __expf(ml - mn);
#pragma unroll
          for (int q = 0; q < 4; ++q)
#pragma unroll
              for (int i = 0; i < 4; ++i) { acc[8 * q + 2 * i] = dec * acc[8 * q + 2 * i] + scl * bflo(cv[q][i]); acc[8 * q + 2 * i + 1] = dec * acc[8 * q + 2 * i + 1] + scl * bfhi(cv[q][i]); }
          an = dec * an + scl * cd; m = mn; }
#pragma unroll
      for (int q = 0; q < 4; ++q) { u32x4 o; o.x = pk2(acc[8 * q], acc[8 * q + 1]); o.y = pk2(acc[8 * q + 2], acc[8 * q + 3]); o.z = pk2(acc[8 * q + 4], acc[8 * q + 5]); o.w = pk2(acc[8 * q + 6], acc[8 * q + 7]);
          *(LAS u32x4*)(F.lds + FM_CT + row * IB + (pc * 4 + q) * 16) = o; }
      if (F.tid < 128) s_n[F.tid] = an; }
    __syncthreads();
    f32x4 st[8];
#pragma unroll
    for (int n = 0; n < 8; ++n) { const u32x2 c = *(const LAS u32x2*)(F.lds + FM_CT + (16 * n + fr) * IB + (16 * w + 4 * fq) * 2); st[n] = (f32x4){bflo(c.x), bfhi(c.x), bflo(c.y), bfhi(c.y)}; }
    const int nt = w & 3, eh = w >> 2, tl = 16 * nt + fr;
    const unsigned trq = (unsigned)(size_t)(F.lds + (fr >> 2) * IB + (4 * (fr & 3)) * 2);
    const unsigned tr_vo = trq + FM_VI + (4 * fq) * IB + 128 * eh;
    const unsigned tr_ka = trq + FM_KE + (8 * fq) * IB + 32 * w, tr_vb = trq + FM_VI + (8 * fq) * IB;
    for (int j = 0; j < 8; ++j) {
        const int c = sc * 8 + j; const size_t row0 = (size_t)b * SEQ + c * 64;
        fm_store<true>(F, R);
        if (w == 0) {
            s_b[lane] = R.gs[0]; s_li[lane] = R.gs[1]; s_e[lane] = R.gs[2]; s_mt[lane] = R.gs[3];
            if (lane == 0) { s_x[0] = R.ml; s_x[1] = R.bl; }
        }
        __syncthreads();
        const u32x4 co0 = R.o0, co1 = R.o1;
        if (j + 1 < 8) fm_load<true>(F, R, b, h, c + 1);
        const float ml = s_x[0], bl = s_x[1]; const float mn = fmaxf(bl + m, ml); const float dec = __expf(bl + m - mn), scl = __expf(ml - mn);
        { const int sp = F.tid >> 4, dg = F.tid & 15, s = 2 * sp, d0 = 8 * dg; float o0[8], o1[8];
          ml_conv2x8(rawq, s, d0, cw + d0, 1.f, o0, o1);
          u32x4 x; x.x = pk2(o0[0], o0[1]); x.y = pk2(o0[2], o0[3]); x.z = pk2(o0[4], o0[5]); x.w = pk2(o0[6], o0[7]); *(LAS u32x4*)(F.lds + FM_QI + s * IB + d0 * 2) = x;
          x.x = pk2(o1[0], o1[1]); x.y = pk2(o1[2], o1[3]); x.z = pk2(o1[4], o1[5]); x.w = pk2(o1[6], o1[7]); *(LAS u32x4*)(F.lds + FM_QI + (s + 1) * IB + d0 * 2) = x;
          ml_conv2x8(rawk, s, d0, cw + 512 + d0, 0.08838834764831845f, o0, o1);
          x.x = pk2(o0[0], o0[1]); x.y = pk2(o0[2], o0[3]); x.z = pk2(o0[4], o0[5]); x.w = pk2(o0[6], o0[7]); *(LAS u32x4*)(F.lds + FM_KI + s * IB + d0 * 2) = x;
          x.x = pk2(o1[0], o1[1]); x.y = pk2(o1[2], o1[3]); x.z = pk2(o1[4], o1[5]); x.w = pk2(o1[6], o1[7]); *(LAS u32x4*)(F.lds + FM_KI + (s + 1) * IB + d0 * 2) = x;
          const float e0 = s_e[s] * scl, e1 = s_e[s + 1] * scl;
          x.x = pk2(o0[0] * e0, o0[1] * e0); x.y = pk2(o0[2] * e0, o0[3] * e0); x.z = pk2(o0[4] * e0, o0[5] * e0); x.w = pk2(o0[6] * e0, o0[7] * e0); *(LAS u32x4*)(F.lds + FM_KE + s * IB + d0 * 2) = x;
          x.x = pk2(o1[0] * e1, o1[1] * e1); x.y = pk2(o1[2] * e1, o1[3] * e1); x.z = pk2(o1[4] * e1, o1[5] * e1); x.w = pk2(o1[6] * e1, o1[7] * e1); *(LAS u32x4*)(F.lds + FM_KE + (s + 1) * IB + d0 * 2) = x; }
        __syncthreads();
        { const int r0 = F.tid >> 4, cc = F.tid & 15;
          *(LAS u32x4*)(F.lds + FM_RAWQ + r0 * IB + cc * 16) = co0; *(LAS u32x4*)(F.lds + FM_RAWQ + (r0 + 32) * IB + cc * 16) = co1; }
        const LAS float* ncur = s_n + (j & 1) * 128; LAS float* nnew = s_n + ((j + 1) & 1) * 128;
        f32x4 ao[4], ai[4]; float a_i, dd;
        { const float bt = s_b[tl], mtt = bt + fmaxf(m, s_mt[tl]); a_i = __expf(bt + m - mtt);
          bf16x8 qf[4];
#pragma unroll
          for (int kk = 0; kk < 4; ++kk) qf[kk] = *(const LAS bf16x8*)(F.lds + FM_QI + tl * IB + (32 * kk + 8 * fq) * 2);
          f32x4 as[4];
#pragma unroll
          for (int ms = 0; ms < 4; ++ms) { as[ms] = (f32x4){0.f, 0.f, 0.f, 0.f};
#pragma unroll
              for (int kk = 0; kk < 4; ++kk) { const bf16x8 ka = *(const LAS bf16x8*)(F.lds + FM_KI + (16 * ms + fr) * IB + (32 * kk + 8 * fq) * 2); as[ms] = MFMA16(ka, qf[kk], as[ms]); } }
          float qn = 0.f;
#pragma unroll
          for (int kk = 0; kk < 4; ++kk) { const f32x4 n0 = *(const LAS f32x4*)(ncur + 32 * kk + 8 * fq), n1 = *(const LAS f32x4*)(ncur + 32 * kk + 8 * fq + 4); const u32x4 qw = __builtin_bit_cast(u32x4, qf[kk]);
              qn += bflo(qw.x) * n0[0] + bfhi(qw.x) * n0[1] + bflo(qw.y) * n0[2] + bfhi(qw.y) * n0[3] + bflo(qw.z) * n1[0] + bfhi(qw.z) * n1[1] + bflo(qw.w) * n1[2] + bfhi(qw.w) * n1[3]; }
          qn += __shfl_xor(qn, 16); qn += __shfl_xor(qn, 32);
          float dsum = 0.f;
          { f32x4 sbv[4], slv[4];
#pragma unroll
            for (int ms = 0; ms < 4; ++ms) { sbv[ms] = *(const LAS f32x4*)(s_b + 16 * ms + 4 * fq); slv[ms] = *(const LAS f32x4*)(s_li + 16 * ms + 4 * fq); }
#pragma unroll
            for (int ms = 0; ms < 4; ++ms) {
#pragma unroll
              for (int r = 0; r < 4; ++r) { const int s = 16 * ms + 4 * fq + r; const float lw = bt - sbv[ms][r] + slv[ms][r] - mtt;
                  const float ex = __builtin_amdgcn_exp2f(lw * 1.4426950408889634f) * as[ms][r];
                  const float wv = (s <= tl) ? ex : 0.f; as[ms][r] = wv; dsum += wv; } } }
          dsum += __shfl_xor(dsum, 16); dsum += __shfl_xor(dsum, 32);
          const float den = dsum + a_i * qn; dd = 1.f / fmaxf(fabsf(den), __expf(-mtt));
#pragma unroll
          for (int n = 0; n < 4; ++n) { ao[n] = (f32x4){0.f, 0.f, 0.f, 0.f}; ai[n] = (f32x4){0.f, 0.f, 0.f, 0.f}; }
#pragma unroll
          for (int k2 = 0; k2 < 2; ++k2) {
              u32x4 pw; pw.x = pk2(as[2 * k2][0], as[2 * k2][1]); pw.y = pk2(as[2 * k2][2], as[2 * k2][3]); pw.z = pk2(as[2 * k2 + 1][0], as[2 * k2 + 1][1]); pw.w = pk2(as[2 * k2 + 1][2], as[2 * k2 + 1][3]);
              const bf16x8 pb = __builtin_bit_cast(bf16x8, pw);
              TrPair pv[4];
#pragma unroll
              for (int n = 0; n < 4; ++n) pv[n] = fm_tr_issue(tr_vo, 32 * k2 * IB + 32 * n, (32 * k2 + 16) * IB + 32 * n);
              TR_WAIT();
#pragma unroll
              for (int n = 0; n < 4; ++n) ao[n] = MFMA16(fm_tr_get(pv[n]), pb, ao[n]); }
#pragma unroll
          for (int kk = 0; kk < 4; ++kk)
#pragma unroll
              for (int n = 0; n < 4; ++n) { const bf16x8 ca = *(const LAS bf16x8*)(F.lds + FM_CT + (64 * eh + 16 * n + fr) * IB + (32 * kk + 8 * fq) * 2); ai[n] = MFMA16(ca, qf[kk], ai[n]); } }
        float q = 0.f;
#pragma unroll
        for (int n = 0; n < 4; ++n)
#pragma unroll
            for (int r = 0; r < 4; ++r) { const float x = (ao[n][r] + a_i * ai[n][r]) * dd; ao[n][r] = x; q += x * x; }
        q += __shfl_xor(q, 16); q += __shfl_xor(q, 32);
        if (fq == 0) s_ss[eh * 64 + tl] = q;
#pragma unroll
        for (int n = 0; n < 8; ++n) st[n] = st[n] * dec;
#pragma unroll
        for (int kk = 0; kk < 2; ++kk) { const TrPair pa = fm_tr_issue(tr_ka, 32 * kk * IB, (32 * kk + 4) * IB); TrPair pb[8];
#pragma unroll
            for (int n = 0; n < 8; ++n) pb[n] = fm_tr_issue(tr_vb, 32 * kk * IB + 32 * n, (32 * kk + 4) * IB + 32 * n);
            TR_WAIT();
            const bf16x8 a = fm_tr_get(pa);
#pragma unroll
            for (int n = 0; n < 8; ++n) st[n] = MFMA16(a, fm_tr_get(pb[n]), st[n]); }
        { const int dk = 16 * w + fr; float s = 0.f;
#pragma unroll
          for (int r = 0; r < 16; ++r) s += bf2f(*(const LAS bf16*)(F.lds + FM_KE + (16 * fq + r) * IB + dk * 2));
          s += __shfl_xor(s, 16); s += __shfl_xor(s, 32);
          if (fq == 0) nnew[dk] = dec * ncur[dk] + s; }
        __syncthreads();
        { const float rn = rsqrtf((s_ss[tl] + s_ss[64 + tl]) * (1.f / 128.f) + EPS);
#pragma unroll
          for (int n = 0; n < 4; ++n) { const int e0 = h * 128 + 64 * eh + 16 * n + 4 * fq; const f32x4 gh = *(const f32x4*)(F.in[7] + e0);
              const u32x2 mo = *(const LAS u32x2*)(F.lds + FM_RAWQ + tl * IB + (64 * eh + 16 * n + 4 * fq) * 2);
              u32x2 o; o.x = pk2(ao[n][0] * rn * gh[0] * sigmoidf_(bflo(mo.x)), ao[n][1] * rn * gh[1] * sigmoidf_(bfhi(mo.x)));
              o.y = pk2(ao[n][2] * rn * gh[2] * sigmoidf_(bflo(mo.y)), ao[n][3] * rn * gh[3] * sigmoidf_(bfhi(mo.y)));
              *(LAS u32x2*)(F.lds + FM_QI + tl * IB + (64 * eh + 16 * n + 4 * fq) * 2) = o; } }
#pragma unroll
        for (int n = 0; n < 8; ++n) { u32x2 o; o.x = pk2(st[n][0], st[n][1]); o.y = pk2(st[n][2], st[n][3]);
            *(LAS u32x2*)(F.lds + FM_CT + (16 * n + fr) * IB + (16 * w + 4 * fq) * 2) = o; }
        m = mn;
        __syncthreads();
        { const int r0 = F.tid >> 4, cc = F.tid & 15;
          *(u32x4*)(MX + (row0 + r0) * D + h * 128 + cc * 8) = *(const LAS u32x4*)(F.lds + FM_QI + r0 * IB + cc * 16);
          *(u32x4*)(MX + (row0 + r0 + 32) * D + h * 128 + cc * 8) = *(const LAS u32x4*)(F.lds + FM_QI + (r0 + 32) * IB + cc * 16); }
    }
}

#ifndef EN_MIX
#define EN_MIX 1
#endif
#ifndef EN_MOE
#define EN_MOE 1
#endif
constexpr int NPH = 13;
__global__ void __launch_bounds__(NTHR, 2) hymba_fwd(Args args) {
    extern __shared__ __attribute__((aligned(16))) unsigned char lds_raw[];
    Frame F;
    F.lds = (LAS unsigned char*)lds_raw;
    F.tid = threadIdx.x; F.lane = F.tid & 63; F.wave = __builtin_amdgcn_readfirstlane(F.tid >> 6);
    F.G = gridDim.x; F.wg = blockIdx.x; F.in = args.in; F.out = args.out; F.ws = args.ws;
    volatile LAS unsigned* MISC = (volatile LAS unsigned*)(F.lds + MISC_OFF);
    if (F.tid < 32) MISC[F.tid] = 0u;
    __syncthreads();
    const int lo = args.ph_lo, hi = args.ph_hi;
    XcdBarrier bar; bar.bar = (unsigned*)(F.ws + WS_CTL) + CW_BAR; bar.x = 0; bar.st = nullptr;
    if (hi - lo > 1) bar = xcd_barrier_post((unsigned*)(F.ws + WS_CTL) + CW_BAR, MISC + 8);
#define IN(k) (lo <= (k) && (k) < hi)
#define SEAM(k) do { if (IN(k) && IN((k) + 1)) xcd_barrier(bar); } while (0)

    if (IN(0)) { p0_weights(F); p0_rows(F); }
    SEAM(0);
    if (IN(1)) {
        { pg8::DenseOrder S; S.init(T, 2048, 1024, F.G, F.wg, WSP(bf16, WS_A64), WSP(bf16, WS_WIN)); S.psplit = 4; S.poff_lo = 0; S.poff_hi = 4;
          pg8::EpiGroup E{WSP(bf16, WS_U), 1.f};
          pg8::gemm_phase<false>(F.lds, 1024, S, E); }
        { pg8::SimpleOrderG<6, 3> S{T / 256, F.G, F.wg, (const char*)F.out, (const char*)WSP(unsigned char, WS_WIN8), (size_t)256 * 1024, 4, 4, 8, (LAS int*)(F.lds + RING_BYTES)};
          S.preload();
          pg8::EpiGroup E{WSP(bf16, WS_U), 1.f / (S8_H1 * S8_W)};
          int k8 = 512; asm volatile("" : "+s"(k8));
          pg8::gemm_phase_fp8<true>(F.lds, k8, S, E); }
    }
    SEAM(1);
    if (IN(2)) {
#if EN_MIX
        p2a_super(F); __syncthreads(); p2d_attention(F, 0, 8);
#endif
    }
    SEAM(2);
    if (IN(4)) {
#if EN_MIX
        p2c_fused(F);
#endif
    }
    SEAM(4);
    if (IN(5)) {
#if EN_MIX
        pg8::DenseOrder S; S.init(T, 1024, 1024, F.G, F.wg, WSP(bf16, WS_A64), WSP(bf16, WS_WOUT));
        pg8::EpiResBf16 E{WSP(bf16, WS_HB), F.in[0], WSP(unsigned char, WS_H8)};
        pg8::gemm_phase<false>(F.lds, 1024, S, E);
#else
        for (size_t i = (size_t)F.wg * NTHR + F.tid; i < (size_t)T * D / 4; i += (size_t)F.G * NTHR) { const f32x4 a = ((const f32x4*)F.in[0])[i]; u32x2 o; o.x = pk2(a[0], a[1]); o.y = pk2(a[2], a[3]); WSP(u32x2, WS_HB)[i] = o; }
#endif
    }
    SEAM(5);
    if (IN(6)) {
#if EN_MOE
        p4_router(F);
#endif
    }
    SEAM(6);
    if (IN(7)) {
#if EN_MOE
        p5_scatter(F);
#endif
    }
    SEAM(7);
    if (IN(8)) {
#if EN_MOE
        const int* pane = WSP(int, MS_PANE);
        { pg8::MoeOrder S{pane[0] * 4, F.G, F.wg, pane, (const char*)WSP(unsigned char, WS_H8), (const char*)WSP(unsigned char, WS_WGU), 0, (size_t)256 * 1024, (size_t)1024 * 1024, WSP(int, MS_ROWTOK), (LAS int*)(F.lds + RING_BYTES), false};
          S.preload();
          pg8::EpiGateUp E{WSP(unsigned char, WS_HID), WSP(float, MS_ROWR)};
          int k8 = 512; asm volatile("" : "+s"(k8));
          pg8::gemm_phase_fp8<true>(F.lds, k8, S, E); }
        { pg8::FillOrder S{pane[0] * 4, 0, 384, F.G, F.wg, 256, (const char*)WSP(bf16, WS_PB), (const char*)WSP(bf16, WS_WPP)};
          pg8::EpiBf16<0> E{WSP(bf16, WS_A64), 1024, nullptr, 1.f, 0};
          int k2 = 256; asm volatile("" : "+s"(k2));
          pg8::gemm_phase<false>(F.lds, k2, S, E); }
#endif
    }
    SEAM(8);
    if (IN(9)) {
#if EN_MOE
        const int* pane = WSP(int, MS_PANE);
        pg8::MoeOrder S{pane[0] * 4, F.G, F.wg, pane, (const char*)WSP(unsigned char, WS_HID), (const char*)WSP(unsigned char, WS_WD), (size_t)256 * 512, (size_t)256 * 512, (size_t)1024 * 512, nullptr, (LAS int*)(F.lds + RING_BYTES), true};
        S.preload();
        pg8::EpiDown E{WSP(unsigned char, WS_XIN), WSP(float, MS_ROWW)};
        int k8 = 256; asm volatile("" : "+s"(k8));
        pg8::gemm_phase_fp8<true>(F.lds, k8, S, E);
        { pg8::FillOrder S2{pane[0] * 4, 384, 512, F.G, F.wg, 256, (const char*)WSP(bf16, WS_PB), (const char*)WSP(bf16, WS_WPP)};
          pg8::EpiBf16<0> E2{WSP(bf16, WS_A64), 1024, nullptr, 1.f, 0};
          int k2 = 256; asm volatile("" : "+s"(k2));
          pg8::gemm_phase<false>(F.lds, k2, S2, E2); }
#endif
    }
    SEAM(9);
    if (IN(10)) {
#if EN_MOE
        p8_rows<true>(F);
#else
        p8_rows<false>(F);
#endif
    }
    SEAM(10);
    if (IN(11)) {
        { pg8::DenseOrderG<2> S; S.init(T, 1024, 512, F.G, F.wg, WSP(unsigned char, WS_H2Q), WSP(unsigned char, WS_WPG)); S.tbl = (LAS int*)(F.lds + RING_BYTES);
          S.preload();
          pg8::EpiBf16<1> E{WSP(bf16, WS_G), 1024, WSP(float, MS_R2), 1.f / (S8_H1 * S8_W), 0};
          int k8 = 512; asm volatile("" : "+s"(k8));
          pg8::gemm_phase_fp8<true>(F.lds, k8, S, E); }
    }
    SEAM(11);
    if (IN(12)) p10_rows(F);
#undef IN
#undef SEAM
}

extern "C" void kernel_launch(void* const* d_in, const int* in_sizes, int n_in, void* d_out, int out_size, void* d_ws, size_t ws_size, hipStream_t stream) {
    static int ready = 0, one_launch = 1;
    if (ready == 0) {
        if (n_in != 22 || out_size != T * D || ws_size < WS_END) { fprintf(stderr, "kernel_launch: unexpected shapes (n_in %d, out %d, ws %zu)\n", n_in, out_size, ws_size); ready = -1; return; }
        if (hipFuncSetAttribute((const void*)hymba_fwd, hipFuncAttributeMaxDynamicSharedMemorySize, LDS_BYTES) != hipSuccess) { fprintf(stderr, "kernel_launch: hipFuncSetAttribute failed\n"); ready = -1; return; }
        int dev = 0, cus = 0, per_cu = 0;
        if (hipGetDevice(&dev) != hipSuccess || hipDeviceGetAttribute(&cus, hipDeviceAttributeMultiprocessorCount, dev) != hipSuccess) cus = 0;
        if (hipOccupancyMaxActiveBlocksPerMultiprocessor(&per_cu, (const void*)hymba_fwd, NTHR, LDS_BYTES) != hipSuccess) per_cu = 0;
        (void)hipGetLastError();
        one_launch = (N_LAUNCHES == 1) && cus >= 256 && per_cu >= 1;
        if (!one_launch && N_LAUNCHES == 1) fprintf(stderr, "kernel_launch: %d CUs, %d blocks per CU: falling back to one launch per phase\n", cus, per_cu);
        ready = 1;
    }
    if (ready < 0) return;
    (void)hipMemsetAsync((char*)d_ws + WS_CTL, 0, CTL_ZERO_BYTES, stream);
    Args a{};
    for (int i = 0; i < 22; ++i) a.in[i] = (const float*)d_in[i];
    a.out = (float*)d_out; a.ws = (unsigned char*)d_ws;
    if (one_launch) {
        a.ph_lo = 0; a.ph_hi = NPH;
        hipLaunchKernelGGL(hymba_fwd, dim3(256), dim3(NTHR), LDS_BYTES, stream, a);
    } else {
        for (int p = 0; p < NPH; ++p) { a.ph_lo = p; a.ph_hi = p + 1; hipLaunchKernelGGL(hymba_fwd, dim3(256), dim3(NTHR), LDS_BYTES, stream, a);
        }
    }
}
```

```cpp
#include <hip/hip_runtime.h>
#include <cstdio>
#include <cstdint>

#ifndef N_LAUNCHES
#define N_LAUNCHES 1
#endif

#define LAS __attribute__((address_space(3)))
typedef unsigned short bf16;
typedef short bf16x8 __attribute__((ext_vector_type(8)));
typedef short s16x4 __attribute__((ext_vector_type(4)));
typedef float f32x4 __attribute__((ext_vector_type(4)));
typedef float f32x2 __attribute__((ext_vector_type(2)));
typedef unsigned u32x4 __attribute__((ext_vector_type(4)));
typedef unsigned u32x2 __attribute__((ext_vector_type(2)));
typedef int v8i32 __attribute__((ext_vector_type(8)));
typedef int v4i32 __attribute__((ext_vector_type(4)));

constexpr int T = 32768, D = 1024, SEQ = 8192, NBATCH = 4;
constexpr int NU = 3584;
constexpr int UQ = 0, UK = 512, UV = 1024, UO = 1536, USQ = 2048, USK = 2560, USV = 3072;
constexpr size_t UGS = (size_t)32768 * 128;
constexpr int GQ = 0, GK = 4, GV = 8, GO = 12, GSQ = 16, GSK = 20, GSV = 24;
constexpr int INC = 3592;
constexpr int NCH = 128;
constexpr int NEXP = 32, DEXP = 512;
constexpr int RMAX = 73728, NPMAX = 288;
constexpr float EPS = 1e-6f;
constexpr int NWAVES = 8, NTHR = 512;

constexpr size_t MiB = 1u << 20;
constexpr size_t WS_CTL = 0, CTL_ZERO_BYTES = 64 * 1024;
constexpr size_t WS_WIN = 1 * MiB, WS_WOUT = 9 * MiB, WS_WPG = 11 * MiB, WS_WPP = 13 * MiB;
constexpr size_t WS_WGU = 14 * MiB, WS_WD = 78 * MiB;
constexpr size_t WS_MISC = 110 * MiB;
constexpr size_t WS_A64 = 116 * MiB;
constexpr size_t WS_U = 180 * MiB;
constexpr size_t WS_XIN = 180 * MiB, WS_HID = 324 * MiB, WS_G = 324 * MiB;
constexpr size_t WS_H2Q = 46 * MiB;
constexpr size_t WS_H8 = 180 * MiB;
constexpr float S8_W = 64.f, S8_H1 = 8.f, S8_HID = 8.f, S8_Y = 32.f;
constexpr size_t WS_C = 404 * MiB;
constexpr size_t WS_HB = 404 * MiB;
constexpr size_t WS_PB = 468 * MiB;
constexpr size_t WS_MISC2 = 484 * MiB;
constexpr size_t WS_END = 488 * MiB;
constexpr size_t MS_GATES = WS_MISC;
constexpr size_t MS_DN = MS_GATES + (size_t)T * 8 * 4;
constexpr size_t MS_MLOC = MS_DN + 2048 * 128 * 4;
constexpr size_t MS_BLAST = MS_MLOC + 2048 * 4;
constexpr size_t MS_MPREV = MS_BLAST + 2048 * 4;
constexpr size_t MS_WRGT = MS_MPREV + 2048 * 4;
constexpr size_t MS_WRET = MS_WRGT + 4 * 1024 * 4;
constexpr size_t MS_RE = MS_WRET + 32 * 1024 * 4;
constexpr size_t MS_RW = MS_RE + (size_t)T * 2 * 4;
constexpr size_t MS_POS = MS_RW + (size_t)T * 2 * 4;
constexpr size_t MS_CNT = MS_POS + (size_t)T * 2 * 4;
constexpr size_t MS_ROWW = MS_CNT + 256 * 32 * 4;
constexpr size_t MS_PANE = MS_ROWW + (size_t)RMAX * 4;
constexpr size_t MS_R1 = MS_PANE + 4096;
constexpr size_t MS_R2 = MS_R1 + (size_t)T * 4;
constexpr size_t MS_ROWR = MS_R2 + (size_t)T * 4;
constexpr size_t MS_END = MS_ROWR + (size_t)RMAX * 4;
constexpr size_t MS_GS = WS_MISC2;
constexpr size_t MS_CH = MS_GS + (size_t)T * 16 * 4;
constexpr size_t MS_WRH = MS_CH + 512 * 8 * 4;
constexpr size_t MS_WRL = MS_WRH + 48 * 1024 * 2;
constexpr size_t MS_ROWTOK = MS_WRL + 48 * 1024 * 2;
constexpr size_t MS2_END = MS_ROWTOK + (size_t)RMAX * 4;
static_assert(MS2_END <= WS_END, "misc region 2");
static_assert(MS_END <= WS_A64, "misc region");
constexpr int CW_BAR = 1024;

constexpr int RING_BYTES = 131072;
constexpr int MISC_OFF = 147456 - 128;
constexpr int LDS_BYTES = 147456;

#define LDS_WAIT() asm volatile("s_waitcnt lgkmcnt(0)" ::: "memory")
#define VM_WAIT() asm volatile("s_waitcnt vmcnt(0)" ::: "memory")
__device__ __forceinline__ unsigned f2bf(float f) { unsigned u = __builtin_bit_cast(unsigned, f); return (u + 0x7fffu + ((u >> 16) & 1u)) >> 16; }
typedef __bf16 bf16x2_t __attribute__((ext_vector_type(2)));
__device__ __forceinline__ unsigned pk2(float lo, float hi) { const f32x2 v = {lo, hi}; return __builtin_bit_cast(unsigned, __builtin_convertvector(v, bf16x2_t)); }
__device__ __forceinline__ float bf2f(unsigned b) { return __builtin_bit_cast(float, b << 16); }
__device__ __forceinline__ float bflo(unsigned w) { return __builtin_bit_cast(float, w << 16); }
__device__ __forceinline__ float bfhi(unsigned w) { return __builtin_bit_cast(float, w & 0xffff0000u); }
__device__ __forceinline__ unsigned pk4_fp8(float a, float b, float c, float d) {
    a = __builtin_amdgcn_fmed3f(a, -448.f, 448.f); b = __builtin_amdgcn_fmed3f(b, -448.f, 448.f); c = __builtin_amdgcn_fmed3f(c, -448.f, 448.f); d = __builtin_amdgcn_fmed3f(d, -448.f, 448.f);
    int p = 0; p = __builtin_amdgcn_cvt_pk_fp8_f32(a, b, p, false); p = __builtin_amdgcn_cvt_pk_fp8_f32(c, d, p, true); return (unsigned)p; }
__device__ __forceinline__ float wave_sum(float v) {
    int x = __builtin_bit_cast(int, v);
#define WS_STEP(ctrl, rmask) { const int y = __builtin_amdgcn_update_dpp(0, x, ctrl, rmask, 0xf, true); x = __builtin_bit_cast(int, __builtin_bit_cast(float, x) + __builtin_bit_cast(float, y)); }
    WS_STEP(0xB1, 0xf)
    WS_STEP(0x4E, 0xf)
    WS_STEP(0x141, 0xf)
    WS_STEP(0x140, 0xf)
    WS_STEP(0x142, 0xa)
    WS_STEP(0x143, 0xc)
#undef WS_STEP
    return __builtin_bit_cast(float, __builtin_amdgcn_readlane(x, 63));
}
__device__ __forceinline__ float wave_max(float v) {
#pragma unroll
    for (int o = 1; o < 64; o <<= 1) v = fmaxf(v, __shfl_xor(v, o));
    return v;
}
__device__ __forceinline__ float sigmoidf_(float x) { return __builtin_amdgcn_rcpf(1.f + __builtin_amdgcn_exp2f(-1.4426950408889634f * x)); }
__device__ __forceinline__ float sigmoid_fast(float x) { return __builtin_amdgcn_rcpf(1.f + __builtin_amdgcn_exp2f(-1.4426950408889634f * x)); }
__device__ __forceinline__ float siluf_(float x) { return x * __builtin_amdgcn_rcpf(1.f + __builtin_amdgcn_exp2f(-1.4426950408889634f * x)); }
__device__ __forceinline__ float log_sigmoidf_(float x) { return fminf(x, 0.f) - log1pf(__expf(-fabsf(x))); }

__device__ __forceinline__ void st_wt16(void* p, u32x4 v) { asm volatile("global_store_dwordx4 %0, %1, off sc1\n\ts_nop 1" :: "v"(p), "v"(v) : "memory"); }
__device__ __forceinline__ void st_wt8(void* p, u32x2 v) { asm volatile("global_store_dwordx2 %0, %1, off sc1" :: "v"(p), "v"(v) : "memory"); }
__device__ __forceinline__ void st_wt4(void* p, unsigned v) { asm volatile("global_store_dword %0, %1, off sc1" :: "v"(p), "v"(v) : "memory"); }
#define MFMA16(a, b, c) __builtin_amdgcn_mfma_f32_16x16x32_bf16((a), (b), (c), 0, 0, 0)

#define XB_TMO      128
#define XB_XCNT(j)  (256  + 64 * (j))
#define XB_XSUB(j)  (1280 + 64 * (j))
#define XB_XGEN(j)  (2304 + 64 * (j))
#define XB_TOP      3328
#define XB_TOPGEN   3392
#define XCD_BAR_WORDS 3456
#define XB_SPIN_CAP (1u << 18)
__device__ __forceinline__ unsigned xb_ld(unsigned* p)              { return __hip_atomic_load(p, __ATOMIC_RELAXED, __HIP_MEMORY_SCOPE_AGENT); }
__device__ __forceinline__ unsigned xb_add(unsigned* p, unsigned v) { return __hip_atomic_fetch_add(p, v, __ATOMIC_RELAXED, __HIP_MEMORY_SCOPE_AGENT); }
__device__ __forceinline__ unsigned xb_xcc_id() { return (unsigned)__builtin_amdgcn_s_getreg((3 << 11) | 20) & 0xFu; }
#define XB_SPIN(cond, bar) do { unsigned _sp = 0; while (cond) { __builtin_amdgcn_s_sleep(1); \
    if ((++_sp & 255u) == 0u) { if (xb_ld(&(bar)[XB_TMO])) break; if (_sp > XB_SPIN_CAP) { atomicAdd(&(bar)[XB_TMO], 1u); break; } } } } while (0)
struct XcdBarrier { unsigned* bar; unsigned x; volatile LAS unsigned* st; };
__device__ __forceinline__ XcdBarrier xcd_barrier_post(unsigned* bar, volatile LAS unsigned* st) {
    XcdBarrier b; b.bar = bar; b.x = xb_xcc_id(); b.st = st;
    if (threadIdx.x == 0) (void)xb_add(&bar[XB_XCNT(b.x)], 1u);
    return b;
}
__device__ __forceinline__ void xcd_barrier_complete(unsigned* bar, unsigned x, unsigned& nloc, unsigned& nx) {
    const unsigned G = gridDim.x * gridDim.y * gridDim.z;
    unsigned sum, cnt, mine, sp = 0u;
    for (;;) {
        sum = 0u; cnt = 0u; mine = 0u;
#pragma unroll
        for (unsigned j = 0; j < 16; ++j) { const unsigned c = xb_ld(&bar[XB_XCNT(j)]); sum += c; cnt += (c > 0u) ? 1u : 0u; mine = (j == x) ? c : mine; }
        if (sum == G) break;
        __builtin_amdgcn_s_sleep(1);
        if ((++sp & 255u) == 0u) { if (xb_ld(&bar[XB_TMO])) break; if (sp > XB_SPIN_CAP) { atomicAdd(&bar[XB_TMO], 1u); break; } }
    }
    nloc = mine > 0u ? mine : 1u; nx = cnt > 0u ? cnt : 1u;
}
__device__ __forceinline__ void xcd_barrier(const XcdBarrier& b) {
    asm volatile("s_waitcnt vmcnt(0)" ::: "memory");
    __syncthreads();
    if (threadIdx.x == 0) {
        unsigned* bar = b.bar;
        __builtin_amdgcn_s_waitcnt(0);
        unsigned nloc = b.st[0], nx = b.st[1];
        if (nloc == 0u) { xcd_barrier_complete(bar, b.x, nloc, nx); b.st[0] = nloc; b.st[1] = nx; }
        const unsigned old = xb_add(&bar[XB_XSUB(b.x)], 1u);
        const unsigned gen = old / nloc;
        if (old + 1u == (gen + 1u) * nloc) {
            __builtin_amdgcn_fence(__ATOMIC_RELEASE, "agent");
            asm volatile("s_waitcnt vmcnt(0)" ::: "memory");
            const unsigned og = xb_add(&bar[XB_TOP], 1u);
            const unsigned tgt = (og / nx + 1u) * nx;
            if (og + 1u != tgt) XB_SPIN(xb_ld(&bar[XB_TOP]) < tgt, bar);
            __builtin_amdgcn_fence(__ATOMIC_ACQUIRE, "agent");
            asm volatile("s_waitcnt vmcnt(0)" ::: "memory");
            xb_add(&bar[XB_XGEN(b.x)], 1u);
            asm volatile("s_waitcnt vmcnt(0)" ::: "memory");
        } else {
            XB_SPIN(xb_ld(&bar[XB_XGEN(b.x)]) == gen, bar);
            asm volatile("buffer_inv sc0" ::: "memory");
            asm volatile("s_waitcnt vmcnt(0)" ::: "memory");
        }
    }
    __syncthreads();
}

namespace pg8 {
constexpr int BM = 256, BK = 64, HALF = 128, HTB = HALF * BK * 2, STAGE_BYTES = 8 * HTB;
__device__ __forceinline__ int lds_byte(int r, int c) { const int st = (r >> 4) * 2 + (c >> 5), rr = r & 15, cc = c & 31, ob = rr * 64 + cc * 2; return st * 1024 + (ob ^ (((ob >> 9) & 1) << 5)); }
__device__ __forceinline__ void stage_rc(int b, int& R, int& C) { const int st = b / 1024, sb = b % 1024, swz = sb ^ (((sb >> 9) & 1) << 5); R = (st >> 1) * 16 + swz / 64; C = (st & 1) * 32 + (swz % 64) / 2; }
__device__ __forceinline__ int perm32(int rho) { const int n = rho >> 4, i = rho & 15; return 8 * (i >> 2) + 4 * n + (i & 3); }
struct Unit { int pm, pn; const char* A; const char* B; int kind; const LAS int* gidx; const LAS float* rf; };
constexpr int FTBL_OFF = 1600;
__device__ __forceinline__ unsigned cvt_pk_bf16(float lo, float hi) { return pk2(lo, hi); }

template <bool GATHER, class Epi, class Sched>
__device__ __forceinline__ void gemm_phase(LAS unsigned char* lds, const int K, const Sched& S, const Epi& E) {
    int tid = threadIdx.x; asm volatile("" : "+v"(tid));
    const int wid = __builtin_amdgcn_readfirstlane(tid >> 6), lane = tid & 63, wr = wid >> 2, wc = wid & 3, fr = lane & 15, fq = lane >> 4;
    const int nt = K / BK;
    unsigned voffA[GATHER ? 2 : 1][2], voffB[2];
    const size_t kstep = (size_t)(BK * 2);
    const size_t hstep = (size_t)HALF * K * 2;
    const size_t ahs = GATHER ? 0 : hstep;
    constexpr int H1 = GATHER ? 1 : 0;
#pragma unroll
    for (int i = 0; i < 2; ++i) { int R, C; stage_rc(tid * 16 + i * 8192, R, C); const int Rb = Epi::PERM ? ((R & ~31) + perm32(R & 31)) : R;
        voffA[0][i] = (unsigned)(R * K + C) * 2u; voffB[i] = (unsigned)(Rb * K + C) * 2u; }
    const unsigned ldsw = (unsigned)wid * 1024u;
    const int aoff = lds_byte(wr * 64 + fr, fq * 8), boff = lds_byte(wc * 32 + fr, fq * 8);
#define PG8_SA(b, h) (((b) * 2 + (h)) * HTB)
#define PG8_SB(b, h) ((4 + (b) * 2 + (h)) * HTB)
#define PG8_STAGE(bufoff, gbase, voff) do { _Pragma("unroll") for (int _i = 0; _i < 2; ++_i) \
        __builtin_amdgcn_global_load_lds((const unsigned*)((const char*)(gbase) + (voff)[_i]), (LAS unsigned*)(lds + (bufoff) + ldsw + _i * 8192), 16, 0, 0); } while (0)
#define PG8_LDA(dst, b, h) do { _Pragma("unroll") for (int m = 0; m < 4; ++m) _Pragma("unroll") for (int k = 0; k < 2; ++k) dst[m][k] = *(const LAS bf16x8*)(lds + PG8_SA(b, h) + aoff + m * 2048 + k * 1024); } while (0)
#define PG8_LDB(dst, b, h) do { _Pragma("unroll") for (int n = 0; n < 2; ++n) _Pragma("unroll") for (int k = 0; k < 2; ++k) dst[n][k] = *(const LAS bf16x8*)(lds + PG8_SB(b, h) + boff + n * 2048 + k * 1024); } while (0)
#define PG8_MMA(ai, bj, At, Bt) do { __builtin_amdgcn_s_setprio(1); _Pragma("unroll") for (int m = 0; m < 4; ++m) _Pragma("unroll") for (int n = 0; n < 2; ++n) _Pragma("unroll") for (int k = 0; k < 2; ++k) \
        acc[ai][bj][m][n] = __builtin_amdgcn_mfma_f32_16x16x32_bf16(Bt[n][k], At[m][k], acc[ai][bj][m][n], 0, 0, 0); __builtin_amdgcn_s_setprio(0); } while (0)
#define PG8_WAIT_V(n) asm volatile("s_waitcnt vmcnt(" #n ")" ::: "memory")
#define PG8_WAIT_L(n) asm volatile("s_waitcnt lgkmcnt(" #n ")" ::: "memory")
#define PG8_BAR __builtin_amdgcn_s_barrier()
#define PG8_SCHED __builtin_amdgcn_sched_barrier(0)
    Unit cur, nxt; int ui = 0;
    if (!S.next(0, cur)) return;
    f32x4 acc[2][2][4][2];
#pragma unroll
    for (int a = 0; a < 2; ++a)
#pragma unroll
        for (int b = 0; b < 2; ++b)
#pragma unroll
            for (int m = 0; m < 4; ++m)
#pragma unroll
                for (int n = 0; n < 2; ++n) acc[a][b][m][n] = (f32x4){0.f, 0.f, 0.f, 0.f};
    bf16x8 At[4][2], B0[2][2], B1[2][2];
    int gi[2][2];
    if (GATHER) {
#pragma unroll
        for (int i = 0; i < 2; ++i) { int R, C; stage_rc(tid * 16 + i * 8192, R, C); const int g0 = cur.gidx[R], g1 = cur.gidx[HALF + R];
            voffA[0][i] = (unsigned)(g0 * K + C) * 2u; voffA[H1][i] = (unsigned)(g1 * K + C) * 2u; } }
    const char* cA = cur.A; const char* cB = cur.B;
    PG8_STAGE(PG8_SB(0, 0), cB, voffB); PG8_STAGE(PG8_SB(0, 1), cB + hstep, voffB); PG8_STAGE(PG8_SA(0, 0), cA, voffA[0]); PG8_STAGE(PG8_SA(0, 1), cA + ahs, voffA[H1]);
    if (wr == 1) PG8_BAR;
    PG8_WAIT_V(2); PG8_BAR;
    PG8_STAGE(PG8_SB(1, 0), cB + kstep, voffB); PG8_STAGE(PG8_SA(1, 0), cA + kstep, voffA[0]); PG8_STAGE(PG8_SB(1, 1), cB + hstep + kstep, voffB);
    PG8_WAIT_V(6); PG8_BAR;
    for (;;) {
        const bool has_next = S.next(ui + 1, nxt);
        const char* nA = has_next ? nxt.A : cA; const char* nB = has_next ? nxt.B : cB;
        if (GATHER && has_next) {
#pragma unroll
            for (int i = 0; i < 2; ++i) { int R, C; stage_rc(tid * 16 + i * 8192, R, C); gi[0][i] = nxt.gidx[R]; gi[1][i] = nxt.gidx[HALF + R]; } }
        for (int t = 0; t < nt; t += 2) {
            const bool last = (t == nt - 2);
            const char* a1 = cA + (size_t)(t + 1) * kstep;
            const char* a2 = last ? nA : cA + (size_t)(t + 2) * kstep; const char* b2 = last ? nB : cB + (size_t)(t + 2) * kstep;
            const char* a3 = a2 + kstep; const char* b3 = b2 + kstep;
            PG8_LDB(B0, 0, 0); PG8_LDB(B1, 0, 1); PG8_SCHED; PG8_LDA(At, 0, 0); PG8_STAGE(PG8_SA(1, 1), a1 + ahs, voffA[H1]);
            if (GATHER && last && has_next) {
#pragma unroll
                for (int i = 0; i < 2; ++i) { int R, C; stage_rc(tid * 16 + i * 8192, R, C);
                    voffA[0][i] = (unsigned)(gi[0][i] * K + C) * 2u; voffA[H1][i] = (unsigned)(gi[1][i] * K + C) * 2u; } }
            PG8_WAIT_V(8); PG8_WAIT_L(0); PG8_BAR; PG8_MMA(0, 0, At, B0); PG8_MMA(0, 1, At, B1); PG8_BAR; PG8_SCHED;
            PG8_LDA(At, 0, 1); PG8_STAGE(PG8_SB(0, 0), b2, voffB); PG8_STAGE(PG8_SB(0, 1), b2 + hstep, voffB); PG8_STAGE(PG8_SA(0, 0), a2, voffA[0]);
            PG8_WAIT_V(8); PG8_WAIT_L(0); PG8_BAR; PG8_MMA(1, 0, At, B0); PG8_MMA(1, 1, At, B1); PG8_BAR; PG8_SCHED;
            PG8_LDB(B0, 1, 0); PG8_LDB(B1, 1, 1); PG8_SCHED; PG8_LDA(At, 1, 0); PG8_STAGE(PG8_SA(0, 1), a2 + ahs, voffA[H1]);
            PG8_WAIT_V(8); PG8_WAIT_L(0); PG8_BAR; PG8_MMA(0, 0, At, B0); PG8_MMA(0, 1, At, B1); PG8_BAR; PG8_SCHED;
            PG8_LDA(At, 1, 1); PG8_STAGE(PG8_SB(1, 0), b3, voffB); PG8_STAGE(PG8_SB(1, 1), b3 + hstep, voffB); PG8_STAGE(PG8_SA(1, 0), a3, voffA[0]);
            PG8_WAIT_V(8); PG8_WAIT_L(0); PG8_BAR; PG8_MMA(1, 0, At, B0); PG8_MMA(1, 1, At, B1); PG8_BAR; PG8_SCHED;
        }
        if (wr == 0) PG8_BAR;
        E(acc, cur, wr, wc, fr, fq);
        if (!has_next) break;
#pragma unroll
        for (int a = 0; a < 2; ++a)
#pragma unroll
            for (int b = 0; b < 2; ++b)
#pragma unroll
                for (int m = 0; m < 4; ++m)
#pragma unroll
                    for (int n = 0; n < 2; ++n) acc[a][b][m][n] = (f32x4){0.f, 0.f, 0.f, 0.f};
        cur = nxt; cA = nA; cB = nB; ++ui;
        if (wr == 1) PG8_BAR;
    }
    PG8_WAIT_V(0);
    PG8_BAR;
#undef PG8_SA
#undef PG8_SB
#undef PG8_STAGE
#undef PG8_LDA
#undef PG8_LDB
#undef PG8_MMA
#undef PG8_WAIT_V
#undef PG8_WAIT_L
#undef PG8_BAR
#undef PG8_SCHED
}

template <bool GATHER, class Epi, class Sched>
__device__ __forceinline__ void gemm_phase_fp8(LAS unsigned char* lds, const int K, const Sched& S, const Epi& E) {
    int tid = threadIdx.x; asm volatile("" : "+v"(tid));
    const int wid = __builtin_amdgcn_readfirstlane(tid >> 6), lane = tid & 63, wr = wid >> 2, wc = wid & 3, fr = lane & 15, fq = lane >> 4;
    const int nt = K / BK;
    unsigned voffA[GATHER ? 2 : 1][2], voffB[2];
    const size_t kstep = (size_t)(BK * 2);
    const size_t hstep = (size_t)HALF * K * 2;
    const size_t ahs = GATHER ? 0 : hstep;
    const size_t bhs = Epi::BPAIR ? (size_t)8 * K * 2 : hstep;
    constexpr int H1 = GATHER ? 1 : 0;
#pragma unroll
    for (int i = 0; i < 2; ++i) { int R, C; stage_rc(tid * 16 + i * 8192, R, C); const int l = perm32(R & 31);
        const int Rb = Epi::BPAIR ? (64 * (R >> 5) + 16 * (l >> 3) + (l & 7)) : (Epi::PERM ? ((R & ~31) + l) : R);
        voffA[0][i] = (unsigned)(R * K + C) * 2u; voffB[i] = (unsigned)(Rb * K + C) * 2u; }
    const unsigned ldsw = (unsigned)wid * 1024u;
    const int aoff = lds_byte(wr * 64 + fr, fq * 8), boff = lds_byte(wc * 32 + fr, fq * 8);
#define PG8_SA(b, h) (((b) * 2 + (h)) * HTB)
#define PG8_SB(b, h) ((4 + (b) * 2 + (h)) * HTB)
#define PG8_STAGE(bufoff, gbase, voff) do { _Pragma("unroll") for (int _i = 0; _i < 2; ++_i) \
        __builtin_amdgcn_global_load_lds((const unsigned*)((const char*)(gbase) + (voff)[_i]), (LAS unsigned*)(lds + (bufoff) + ldsw + _i * 8192), 16, 0, 0); } while (0)
#define PG8_LD8(addr) __builtin_shufflevector(*(const LAS v4i32*)(addr), *(const LAS v4i32*)((addr) + 1024), 0, 1, 2, 3, 4, 5, 6, 7)
#define PG8_LDA(dst, b, h) do { _Pragma("unroll") for (int m = 0; m < 4; ++m) dst[m] = PG8_LD8(lds + PG8_SA(b, h) + aoff + m * 2048); } while (0)
#define PG8_LDB(dst, b, h) do { _Pragma("unroll") for (int n = 0; n < 2; ++n) dst[n] = PG8_LD8(lds + PG8_SB(b, h) + boff + n * 2048); } while (0)
#define PG8_MMA(ai, bj, At, Bt) do { __builtin_amdgcn_s_setprio(1); _Pragma("unroll") for (int m = 0; m < 4; ++m) _Pragma("unroll") for (int n = 0; n < 2; ++n) \
        acc[ai][bj][m][n] = __builtin_amdgcn_mfma_scale_f32_16x16x128_f8f6f4(Bt[n], At[m], acc[ai][bj][m][n], 0, 0, 0, 0x7F7F7F7F, 0, 0x7F7F7F7F); __builtin_amdgcn_s_setprio(0); } while (0)
#define PG8_WAIT_V(n) asm volatile("s_waitcnt vmcnt(" #n ")" ::: "memory")
#define PG8_WAIT_L(n) asm volatile("s_waitcnt lgkmcnt(" #n ")" ::: "memory")
#define PG8_BAR __builtin_amdgcn_s_barrier()
#define PG8_SCHED __builtin_amdgcn_sched_barrier(0)
    Unit cur, nxt; int ui = 0;
    if (!S.next(0, cur)) return;
    f32x4 acc[2][2][4][2];
#pragma unroll
    for (int a = 0; a < 2; ++a)
#pragma unroll
        for (int b = 0; b < 2; ++b)
#pragma unroll
            for (int m = 0; m < 4; ++m)
#pragma unroll
                for (int n = 0; n < 2; ++n) acc[a][b][m][n] = (f32x4){0.f, 0.f, 0.f, 0.f};
    v8i32 At[4], B0[2], B1[2];
    int gi[2][2];
    if (GATHER) {
#pragma unroll
        for (int i = 0; i < 2; ++i) { int R, C; stage_rc(tid * 16 + i * 8192, R, C); const int g0 = cur.gidx[R], g1 = cur.gidx[HALF + R];
            voffA[0][i] = (unsigned)(g0 * K + C) * 2u; voffA[H1][i] = (unsigned)(g1 * K + C) * 2u; } }
    const char* cA = cur.A; const char* cB = cur.B;
    PG8_STAGE(PG8_SB(0, 0), cB, voffB); PG8_STAGE(PG8_SB(0, 1), cB + bhs, voffB); PG8_STAGE(PG8_SA(0, 0), cA, voffA[0]); PG8_STAGE(PG8_SA(0, 1), cA + ahs, voffA[H1]);
    if (wr == 1) PG8_BAR;
    PG8_WAIT_V(2); PG8_BAR;
    PG8_STAGE(PG8_SB(1, 0), cB + kstep, voffB); PG8_STAGE(PG8_SA(1, 0), cA + kstep, voffA[0]); PG8_STAGE(PG8_SB(1, 1), cB + bhs + kstep, voffB);
    PG8_WAIT_V(6); PG8_BAR;
    for (;;) {
        const bool has_next = S.next(ui + 1, nxt);
        const char* nA = has_next ? nxt.A : cA; const char* nB = has_next ? nxt.B : cB;
        if (GATHER && has_next) {
#pragma unroll
            for (int i = 0; i < 2; ++i) { int R, C; stage_rc(tid * 16 + i * 8192, R, C); gi[0][i] = nxt.gidx[R]; gi[1][i] = nxt.gidx[HALF + R]; } }
        for (int t = 0; t < nt; t += 2) {
            const bool last = (t == nt - 2);
            const char* a1 = cA + (size_t)(t + 1) * kstep;
            const char* a2 = last ? nA : cA + (size_t)(t + 2) * kstep; const char* b2 = last ? nB : cB + (size_t)(t + 2) * kstep;
            const char* a3 = a2 + kstep; const char* b3 = b2 + kstep;
            PG8_LDB(B0, 0, 0); PG8_LDB(B1, 0, 1); PG8_SCHED; PG8_LDA(At, 0, 0); PG8_STAGE(PG8_SA(1, 1), a1 + ahs, voffA[H1]);
            if (GATHER && last && has_next) {
#pragma unroll
                for (int i = 0; i < 2; ++i) { int R, C; stage_rc(tid * 16 + i * 8192, R, C);
                    voffA[0][i] = (unsigned)(gi[0][i] * K + C) * 2u; voffA[H1][i] = (unsigned)(gi[1][i] * K + C) * 2u; } }
            PG8_WAIT_V(8); PG8_WAIT_L(0); PG8_BAR; PG8_MMA(0, 0, At, B0); PG8_MMA(0, 1, At, B1); PG8_BAR; PG8_SCHED;
            PG8_LDA(At, 0, 1); PG8_STAGE(PG8_SB(0, 0), b2, voffB); PG8_STAGE(PG8_SB(0, 1), b2 + bhs, voffB); PG8_STAGE(PG8_SA(0, 0), a2, voffA[0]);
            PG8_WAIT_V(8); PG8_WAIT_L(0); PG8_BAR; PG8_MMA(1, 0, At, B0); PG8_MMA(1, 1, At, B1); PG8_BAR; PG8_SCHED;
            PG8_LDB(B0, 1, 0); PG8_LDB(B1, 1, 1); PG8_SCHED; PG8_LDA(At, 1, 0); PG8_STAGE(PG8_SA(0, 1), a2 + ahs, voffA[H1]);
            PG8_WAIT_V(8); PG8_WAIT_L(0); PG8_BAR; PG8_MMA(0, 0, At, B0); PG8_MMA(0, 1, At, B1); PG8_BAR; PG8_SCHED;
            PG8_LDA(At, 1, 1); PG8_STAGE(PG8_SB(1, 0), b3, voffB); PG8_STAGE(PG8_SB(1, 1), b3 + bhs, voffB); PG8_STAGE(PG8_SA(1, 0), a3, voffA[0]);
            PG8_WAIT_V(8); PG8_WAIT_L(0); PG8_BAR; PG8_MMA(1, 0, At, B0); PG8_MMA(1, 1, At, B1); PG8_BAR; PG8_SCHED;
        }
        if (wr == 0) PG8_BAR;
        E(acc, cur, wr, wc, fr, fq);
        if (!has_next) break;
#pragma unroll
        for (int a = 0; a < 2; ++a)
#pragma unroll
            for (int b = 0; b < 2; ++b)
#pragma unroll
                for (int m = 0; m < 4; ++m)
#pragma unroll
                    for (int n = 0; n < 2; ++n) acc[a][b][m][n] = (f32x4){0.f, 0.f, 0.f, 0.f};
        cur = nxt; cA = nA; cB = nB; ++ui;
        if (wr == 1) PG8_BAR;
    }
    PG8_WAIT_V(0);
    PG8_BAR;
#undef PG8_SA
#undef PG8_SB
#undef PG8_STAGE
#undef PG8_LDA
#undef PG8_LDB
#undef PG8_MMA
#undef PG8_LD8
#undef PG8_WAIT_V
#undef PG8_WAIT_L
#undef PG8_BAR
#undef PG8_SCHED
}

struct DenseOrder {
    int nM, nN, nwg, G, c, K; const char* A; const char* B; size_t tstep;
    __device__ __forceinline__ void init(int M, int N, int K_, int G_, int c_, const void* A_, const void* B_) { nM = M / BM; nN = N / BM; nwg = nM * nN; G = G_; c = c_; K = K_; A = (const char*)A_; B = (const char*)B_; tstep = (size_t)BM * K * 2; }
    int ioff = 0, icnt = 1 << 20;
    __device__ __forceinline__ bool next(int i0, Unit& u) const {
        if (i0 >= icnt) return false;
        const int i = i0 + ioff;
        const long L = (long)i * G + c; if (L >= nwg) return false;
        int wgid = (int)L; { const int q = nwg / 8, r = nwg % 8, xcd = wgid % 8, off = wgid / 8; wgid = (xcd < r ? xcd * (q + 1) : r * (q + 1) + (xcd - r) * q) + off; }
        const int nig = 8 * nN, gid = wgid / nig, fm = gid * 8, gsz = (nM - fm) < 8 ? (nM - fm) : 8;
        u.pm = fm + ((wgid % nig) % gsz); u.pn = (wgid % nig) / gsz; u.A = A + (size_t)u.pm * tstep; u.B = B + (size_t)u.pn * tstep; u.kind = 0; u.gidx = (const LAS int*)0; u.rf = (const LAS float*)0; return true;
    }
};
template <int NT> struct DenseOrderG : DenseOrder {
    LAS int* tbl; const float* rowfac;
    __device__ __forceinline__ void preload() const {
#pragma unroll
        for (int i = 0; i < NT; ++i) { Unit u; if (DenseOrder::next(i, u) && threadIdx.x < 256) { tbl[256 * i + threadIdx.x] = u.pm * 256 + threadIdx.x; ((LAS float*)(tbl + FTBL_OFF))[256 * i + threadIdx.x] = rowfac[u.pm * 256 + threadIdx.x]; } }
        __syncthreads();
    }
    __device__ __forceinline__ bool next(int i, Unit& u) const {
        if (i >= NT || !DenseOrder::next(i, u)) return false;
        u.A = A; u.gidx = tbl + 256 * i; u.rf = (const LAS float*)(tbl + FTBL_OFF) + 256 * i; return true;
    }
};
struct MoeOrder {
    int nunits, G, c0; const int* pane; const char* A; const char* B; size_t atstep, btstep, estep;
    const int* rowtok;
    LAS int* tbl;
    bool ident;
    const float* rowfac;
    __device__ __forceinline__ void preload() const {
        const int c = (c0 & 7) * (G >> 3) + (c0 >> 3), t = threadIdx.x;
#pragma unroll
        for (int i = 0; i < 6; ++i) { const int L = i * G + c;
            if (L < nunits) { const int pm = L >> 2;
                if (t == 256 + i) tbl[i] = pane[1 + pm];
                if (rowtok && t < 256) tbl[8 + 256 * i + t] = rowtok[pm * 256 + t];
                if (ident && t < 256) tbl[8 + 256 * i + t] = pm * 256 + t;
                if (t < 256) ((LAS float*)(tbl + FTBL_OFF))[256 * i + t] = rowfac[pm * 256 + t]; } }
        __syncthreads();
    }
    __device__ __forceinline__ bool next(int i, Unit& u) const {
        const int c = (c0 & 7) * (G >> 3) + (c0 >> 3);
        const int L = i * G + c; if (L >= nunits || i >= 6) return false;
        u.pm = L >> 2; u.pn = L & 3; const int e = __builtin_amdgcn_readfirstlane(tbl[i]);
        u.A = (rowtok || ident) ? A : A + (size_t)u.pm * atstep; u.gidx = tbl + 8 + 256 * i;
        u.B = B + (size_t)e * estep + (size_t)u.pn * btstep; u.kind = 0; u.rf = (const LAS float*)(tbl + FTBL_OFF) + 256 * i; return true;
    }
};
struct FillOrder {
    int nunits, f0, nfill, G, c0, K2; const char* A2; const char* B2;
    __device__ __forceinline__ bool next(int i, Unit& u) const {
        const int c = (c0 & 7) * (G >> 3) + (c0 >> 3);
        const int r = nunits % G; if (c < r) return false;
        const int j = f0 + (c - r) + i * (G - r); if (j >= nfill) return false;
        u.pm = j >> 2; u.pn = j & 3; u.A = A2 + (size_t)u.pm * BM * K2 * 2; u.B = B2 + (size_t)u.pn * BM * K2 * 2; u.kind = 1; u.gidx = (const LAS int*)0; u.rf = (const LAS float*)0; return true;
    }
};

template <int ACT  > struct EpiBf16 {
    static constexpr bool PERM = true, BPAIR = false;
    bf16* O; int ldc; const float* rs; float rmul; size_t gstride;
    __device__ __forceinline__ void operator()(const f32x4 (&acc)[2][2][4][2], const Unit& u, int wr, int wc, int fr, int fq) const {
        const int row0 = u.pm * BM + wr * 64 + fr; const int col0 = gstride ? wc * 32 + 8 * fq : u.pn * BM + wc * 32 + 8 * fq;
        const size_t bjs = gstride ? gstride : (size_t)HALF; bf16* const Ob = O + (gstride ? (size_t)(2 * u.pn) * gstride : 0);
        float rsv[2][4];
#pragma unroll
        for (int ai = 0; ai < 2; ++ai)
#pragma unroll
            for (int m = 0; m < 4; ++m) rsv[ai][m] = (ACT != 0) ? u.rf[wr * 64 + fr + ai * HALF + m * 16] * rmul : 1.f;
#pragma unroll
        for (int ai = 0; ai < 2; ++ai)
#pragma unroll
            for (int m = 0; m < 4; ++m) { const int row = row0 + ai * HALF + m * 16; bf16* rowp = Ob + (size_t)row * ldc + col0; const float rsc = rsv[ai][m];
#pragma unroll
                for (int bj = 0; bj < 2; ++bj) { f32x4 v0 = acc[ai][bj][m][0], v1 = acc[ai][bj][m][1];
                    if (ACT == 1) {
#pragma unroll
                        for (int j = 0; j < 4; ++j) { v0[j] = sigmoidf_(v0[j] * rsc); v1[j] = sigmoidf_(v1[j] * rsc); } }
                    if (ACT == 2) { v0 = v0 * rsc; v1 = v1 * rsc; }
                    u32x4 w; w.x = cvt_pk_bf16(v0[0], v0[1]); w.y = cvt_pk_bf16(v0[2], v0[3]); w.z = cvt_pk_bf16(v1[0], v1[1]); w.w = cvt_pk_bf16(v1[2], v1[3]);
                    { const unsigned so = (unsigned)(((size_t)row * ldc + col0 + bj * bjs) * 2);
                      asm volatile("global_store_dwordx4 %0, %1, %2 sc1\n\ts_nop 1" :: "v"(so), "v"(w), "s"(Ob) : "memory"); } } }
    }
};
struct EpiResBf16 {
    static constexpr bool PERM = true;
    bf16* H; const float* R; unsigned char* H8;
    __device__ __forceinline__ void operator()(const f32x4 (&acc)[2][2][4][2], const Unit& u, int wr, int wc, int fr, int fq) const {
        const int row0 = u.pm * BM + wr * 64 + fr, col0 = u.pn * BM + wc * 32 + 8 * fq;
#pragma unroll
        for (int ai = 0; ai < 2; ++ai) {
            f32x4 rv[4][2][2];
#pragma unroll
            for (int m = 0; m < 4; ++m)
#pragma unroll
                for (int bj = 0; bj < 2; ++bj) { const size_t ro = (size_t)(row0 + ai * HALF + m * 16) * 1024 + col0 + bj * HALF; rv[m][bj][0] = __builtin_nontemporal_load((const f32x4*)(R + ro)); rv[m][bj][1] = __builtin_nontemporal_load((const f32x4*)(R + ro + 4)); }
#pragma unroll
            for (int m = 0; m < 4; ++m) { const size_t ro = (size_t)(row0 + ai * HALF + m * 16) * 1024 + col0;
#pragma unroll
                for (int bj = 0; bj < 2; ++bj) { const f32x4 r0 = rv[m][bj][0], r1 = rv[m][bj][1];
                    const f32x4 v0 = acc[ai][bj][m][0] + r0, v1 = acc[ai][bj][m][1] + r1;
                    u32x4 w; w.x = cvt_pk_bf16(v0[0], v0[1]); w.y = cvt_pk_bf16(v0[2], v0[3]); w.z = cvt_pk_bf16(v1[0], v1[1]); w.w = cvt_pk_bf16(v1[2], v1[3]);
                    *(u32x4*)(H + ro + bj * HALF) = w;
                    u32x2 q; q.x = pk4_fp8(v0[0] * S8_H1, v0[1] * S8_H1, v0[2] * S8_H1, v0[3] * S8_H1); q.y = pk4_fp8(v1[0] * S8_H1, v1[1] * S8_H1, v1[2] * S8_H1, v1[3] * S8_H1);
                    *(u32x2*)(H8 + ro + bj * HALF) = q; } } }
    }
};
struct EpiGateUp {
    static constexpr bool PERM = true, BPAIR = false;
    unsigned char* H; const float* rowr;
    __device__ __forceinline__ void operator()(const f32x4 (&acc)[2][2][4][2], const Unit& u, int wr, int wc, int fr, int fq) const {
        const int row0 = u.pm * BM + wr * 64 + fr, col0 = u.pn * 128 + wc * 32 + 8 * fq;
        float rsv[2][4];
#pragma unroll
        for (int ai = 0; ai < 2; ++ai)
#pragma unroll
            for (int m = 0; m < 4; ++m) rsv[ai][m] = u.rf[wr * 64 + fr + ai * HALF + m * 16] * (1.f / (S8_H1 * S8_W));
#pragma unroll
        for (int ai = 0; ai < 2; ++ai)
#pragma unroll
            for (int m = 0; m < 4; ++m) { const int row = row0 + ai * HALF + m * 16; unsigned char* rowp = H + (size_t)row * DEXP + col0; const float rr = rsv[ai][m];
                f32x4 v0, v1;
#pragma unroll
                for (int j = 0; j < 4; ++j) { v0[j] = siluf_(acc[ai][0][m][0][j] * rr) * (acc[ai][1][m][0][j] * rr) * S8_HID; v1[j] = siluf_(acc[ai][0][m][1][j] * rr) * (acc[ai][1][m][1][j] * rr) * S8_HID; }
                u32x2 w; w.x = pk4_fp8(v0[0], v0[1], v0[2], v0[3]); w.y = pk4_fp8(v1[0], v1[1], v1[2], v1[3]);
                { const unsigned so = (unsigned)((size_t)row * DEXP + col0); asm volatile("global_store_dwordx2 %0, %1, %2 sc1" :: "v"(so), "v"(w), "s"(H) : "memory"); } }
    }
};
struct EpiDown {
    static constexpr bool PERM = true, BPAIR = true;
    unsigned char* Y; const float* roww;
    __device__ __forceinline__ void operator()(const f32x4 (&acc)[2][2][4][2], const Unit& u, int wr, int wc, int fr, int fq) const {
        const int row0 = u.pm * BM + wr * 64 + fr, col0 = u.pn * BM + wc * 64 + 16 * fq;
        float rsv[2][4];
#pragma unroll
        for (int ai = 0; ai < 2; ++ai)
#pragma unroll
            for (int m = 0; m < 4; ++m) rsv[ai][m] = u.rf[wr * 64 + fr + ai * HALF + m * 16] * (S8_Y / (S8_HID * S8_W));
#pragma unroll
        for (int ai = 0; ai < 2; ++ai)
#pragma unroll
            for (int m = 0; m < 4; ++m) { const float w8 = rsv[ai][m]; u32x4 w;
                { const f32x4 v0 = acc[ai][0][m][0] * w8, v1 = acc[ai][0][m][1] * w8; w.x = pk4_fp8(v0[0], v0[1], v0[2], v0[3]); w.y = pk4_fp8(v1[0], v1[1], v1[2], v1[3]); }
                { const f32x4 v0 = acc[ai][1][m][0] * w8, v1 = acc[ai][1][m][1] * w8; w.z = pk4_fp8(v0[0], v0[1], v0[2], v0[3]); w.w = pk4_fp8(v1[0], v1[1], v1[2], v1[3]); }
                { const unsigned so = (unsigned)((size_t)(row0 + ai * HALF + m * 16) * 1024 + col0); asm volatile("global_store_dwordx4 %0, %1, %2 sc1\n\ts_nop 1" :: "v"(so), "v"(w), "s"(Y) : "memory"); } }
    }
};
}

struct Args { const float* in[22]; float* out; unsigned char* ws; int ph_lo, ph_hi; };
struct Frame {
    LAS unsigned char* lds; int tid, lane, wave, G, wg;
    const float* const* in; float* out; unsigned char* ws;
};
#define WSP(T_, off) ((T_*)(F.ws + (off)))

__device__ __forceinline__ void transpose_item(const float* W, int ldw, int k0, int nsrc0, bf16* WT, int Kdst, int ndst0, LAS float* scr, int lane, const float* ksc = nullptr, unsigned char* f8 = nullptr) {
    float tv[32];
#pragma unroll
    for (int i = 0; i < 32; ++i) tv[i] = __builtin_nontemporal_load(&W[(size_t)(k0 + 2 * i + (lane >> 5)) * ldw + nsrc0 + (lane & 31)]);
    if (ksc) {
#pragma unroll
        for (int i = 0; i < 32; ++i) tv[i] *= ksc[k0 + 2 * i + (lane >> 5)]; }
#pragma unroll
    for (int i = 0; i < 32; ++i) scr[(2 * i + (lane >> 5)) * 33 + (lane & 31)] = tv[i];
    LDS_WAIT();
    const int c = lane & 7;
#pragma unroll
    for (int j = 0; j < 4; ++j) { const int n = (lane >> 3) + 8 * j; const LAS float* s = scr + (8 * c) * 33 + n;
        if (f8) { u32x2 o; o.x = pk4_fp8(s[0 * 33] * S8_W, s[1 * 33] * S8_W, s[2 * 33] * S8_W, s[3 * 33] * S8_W); o.y = pk4_fp8(s[4 * 33] * S8_W, s[5 * 33] * S8_W, s[6 * 33] * S8_W, s[7 * 33] * S8_W);
            *(u32x2*)(f8 + (size_t)(ndst0 + n) * Kdst + k0 + 8 * c) = o; }
        else { u32x4 o; o.x = pk2(s[0 * 33], s[1 * 33]); o.y = pk2(s[2 * 33], s[3 * 33]); o.z = pk2(s[4 * 33], s[5 * 33]); o.w = pk2(s[6 * 33], s[7 * 33]);
            *(u32x4*)(WT + (size_t)(ndst0 + n) * Kdst + k0 + 8 * c) = o; } }
    LDS_WAIT();
}
constexpr int P0_JE = 1024 + 768 + 512 + 512 + 128, P0_JX = P0_JE + 3 * 8192;
__device__ __forceinline__ void p0_weights(Frame& F) {
    LAS float* scr = (LAS float*)(F.lds + F.wave * 9216);
    const int gw = F.wg * NWAVES + F.wave, NGW = F.G * NWAVES;
    constexpr int J0 = 1024, J1 = J0 + 768, J2 = J1 + 512, J3 = J2 + 512, J4 = J3 + 128;
    static_assert(J4 == P0_JE, "item ranges");
    for (int it = gw; it < J4; it += NGW) {
        if (it < J0) { const int r = it, kb = r / 64, nb = r % 64; transpose_item(F.in[3], INC, 64 * kb, 32 * nb, WSP(bf16, WS_WIN), 1024, 32 * nb, scr, F.lane); }
        else if (it < J1) { const int r = it - J0, kb = r / 48, nb = r % 48; transpose_item(F.in[3], INC, 64 * kb, 2056 + 32 * nb, WSP(bf16, WS_WIN), 1024, 2048 + 32 * nb, scr, F.lane); }
        else if (it < J2) { const int r = it - J1, kb = r / 32, nb = r % 32; transpose_item(F.in[8], 1024, 64 * kb, 32 * nb, WSP(bf16, WS_WOUT), 1024, 32 * nb, scr, F.lane); }
        else if (it < J3) { const int r = it - J2, kb = r / 32, nb = r % 32; transpose_item(F.in[18], 1024, 64 * kb, 32 * nb, nullptr, 1024, 32 * nb, scr, F.lane, F.in[17], WSP(unsigned char, WS_WPG)); }
        else { const int r = it - J3, kb = r / 32, nb = r % 32; transpose_item(F.in[19], 1024, 64 * kb, 32 * nb, WSP(bf16, WS_WPP), 256, 32 * nb, scr, F.lane); }
    }
    const int gt = F.wg * NTHR + F.tid, NGT = F.G * NTHR;
    for (int i = gt; i < 48 * 1024; i += NGT) { const int j = i >> 10, k = i & 1023;
        const float w = (j < 36) ? F.in[9][k] * ((j < 4) ? F.in[10][k * 4 + j] : F.in[12][k * 32 + (j - 4)]) : 0.f;
        const unsigned hi = f2bf(w); const unsigned lo = f2bf(w - bf2f(hi));
        WSP(bf16, MS_WRH)[i] = (bf16)hi; WSP(bf16, MS_WRL)[i] = (bf16)lo; }
}
__device__ __forceinline__ void p0_pconv(Frame& F) {
    const int gt = F.wg * NTHR + F.tid, NGT = F.G * NTHR;
#pragma unroll 4
    for (int i = gt; i < T * 256 / 8; i += NGT) { const f32x4 a = __builtin_nontemporal_load((const f32x4*)F.in[1] + 2 * i), b = __builtin_nontemporal_load((const f32x4*)F.in[1] + 2 * i + 1);
        u32x4 o; o.x = pk2(a[0], a[1]); o.y = pk2(a[2], a[3]); o.z = pk2(b[0], b[1]); o.w = pk2(b[2], b[3]); WSP(u32x4, WS_PB)[i] = o; }
}
struct LateItem { const float* W; int ldw, k0, n0, Kdst, ndst0; const float* ksc; unsigned char* f8; };
__device__ __forceinline__ LateItem late_item(Frame& F, int it) {
    LateItem I; const int r = it - P0_JE;
    if (r < 16384) { const int up = r >= 8192, r2 = r & 8191, e = r2 >> 8, q = r2 & 255, kb = q >> 4, nb = q & 15, n0 = 32 * nb;
        I.W = F.in[up ? 15 : 14] + (size_t)e * 1024 * 512; I.ldw = 512; I.k0 = 64 * kb; I.n0 = n0; I.Kdst = 1024; I.ndst0 = (n0 >> 7) * 256 + (n0 & 127) + (up ? 128 : 0); I.ksc = F.in[9];
        I.f8 = WSP(unsigned char, WS_WGU) + (size_t)e * 1024 * 1024; }
    else { const int r3 = r - 16384, e = r3 >> 8, q = r3 & 255, kb = q >> 5, nb = q & 31;
        I.W = F.in[16] + (size_t)e * 512 * 1024; I.ldw = 1024; I.k0 = 64 * kb; I.n0 = 32 * nb; I.Kdst = 512; I.ndst0 = 32 * nb; I.ksc = nullptr; I.f8 = WSP(unsigned char, WS_WD) + (size_t)e * 1024 * 512; }
    return I;
}
constexpr int LB = 4;
__device__ __forceinline__ void p0_late(Frame& F, int k_lo, int k_hi) {
    LAS float* scr = (LAS float*)(F.lds + F.wave * 9216);
    const int gw = F.wg * NWAVES + F.wave, NGW = F.G * NWAVES, lane = F.lane, lr = lane >> 3, lc = lane & 7;
    LAS float* gl = (LAS float*)(F.lds + 73728);
    for (int i = F.tid; i < 1024; i += NTHR) gl[i] = F.in[9][i];
    __syncthreads();
    for (int k = k_lo; k < k_hi; k += LB) {
        f32x4 tv[LB][8];
#pragma unroll
        for (int b = 0; b < LB; ++b) { const LateItem I = late_item(F, P0_JE + gw + (k + b) * NGW);
#pragma unroll
            for (int i = 0; i < 8; ++i) tv[b][i] = __builtin_nontemporal_load((const f32x4*)(I.W + (size_t)(I.k0 + 8 * i + lr) * I.ldw + I.n0 + 4 * lc)); }
#pragma unroll
        for (int b = 0; b < LB; ++b) { { const LateItem I = late_item(F, P0_JE + gw + (k + b) * NGW);
#pragma unroll
                for (int i = 0; i < 8; ++i) { const float gv = gl[I.k0 + 8 * i + lr], g = I.ksc ? gv : 1.f; LAS float* d = scr + (8 * i + lr) * 33 + 4 * lc;
                    d[0] = tv[b][i][0] * g; d[1] = tv[b][i][1] * g; d[2] = tv[b][i][2] * g; d[3] = tv[b][i][3] * g; }
                LDS_WAIT();
#pragma unroll
                for (int j = 0; j < 4; ++j) { const int n = lr + 8 * j; const LAS float* sp = scr + (8 * lc) * 33 + n;
                    u32x2 o; o.x = pk4_fp8(sp[0 * 33] * S8_W, sp[1 * 33] * S8_W, sp[2 * 33] * S8_W, sp[3 * 33] * S8_W); o.y = pk4_fp8(sp[4 * 33] * S8_W, sp[5 * 33] * S8_W, sp[6 * 33] * S8_W, sp[7 * 33] * S8_W);
                    *(u32x2*)(I.f8 + (size_t)(I.ndst0 + n) * I.Kdst + I.k0 + 8 * lc) = o; }
                LDS_WAIT(); } }
    }
}
__device__ __forceinline__ void p0_rows(Frame& F) {
    LAS float* wg8 = (LAS float*)(F.lds + 73728);
    __syncthreads();
    { float t[16];
#pragma unroll
      for (int q = 0; q < 16; ++q) { const int i = F.tid + NTHR * q, k = i >> 3, j = i & 7; t[q] = F.in[3][(size_t)k * INC + 2048 + j]; }
#pragma unroll
      for (int q = 0; q < 16; ++q) { const int i = F.tid + NTHR * q, k = i >> 3, j = i & 7; wg8[j * 1024 + k] = t[q]; } }
    __syncthreads();
    const int gw = F.wg * NWAVES + F.wave, NGW = F.G * NWAVES;
    f32x4 g[4];
#pragma unroll
    for (int j = 0; j < 4; ++j) g[j] = ((const f32x4*)F.in[2])[F.lane + 64 * j];
    const float bg = F.in[4][F.lane >> 3];
    f32x4 nx[4];
#pragma unroll
    for (int j = 0; j < 4; ++j) nx[j] = __builtin_nontemporal_load((const f32x4*)(F.in[0] + (size_t)gw * D) + F.lane + 64 * j);
    for (int m = gw; m < T; m += NGW) {
        f32x4 v[4]; float s = 0.f;
#pragma unroll
        for (int j = 0; j < 4; ++j) v[j] = nx[j];
        if (m + NGW < T) {
#pragma unroll
            for (int j = 0; j < 4; ++j) nx[j] = __builtin_nontemporal_load((const f32x4*)(F.in[0] + (size_t)(m + NGW) * D) + F.lane + 64 * j); }
#pragma unroll
        for (int j = 0; j < 4; ++j) s += (v[j].x * v[j].x + v[j].y * v[j].y) + (v[j].z * v[j].z + v[j].w * v[j].w);
        const float r = rsqrtf(wave_sum(s) * (1.f / D) + EPS);
#pragma unroll
        for (int j = 0; j < 4; ++j) v[j] = v[j] * r * g[j];
        u32x2* o8 = (u32x2*)(WSP(bf16, WS_A64) + (size_t)m * D) + F.lane;
#pragma unroll
        for (int j = 0; j < 4; ++j) { u32x2 o; o.x = pk2(v[j].x, v[j].y); o.y = pk2(v[j].z, v[j].w); o8[64 * j] = o; }
        float ga[8];
#pragma unroll
        for (int gi = 0; gi < 8; ++gi) { float a = 0.f;
#pragma unroll
            for (int j = 0; j < 4; ++j) { const f32x4 w = *(const LAS f32x4*)(wg8 + gi * 1024 + 4 * F.lane + 256 * j); a += (v[j].x * w.x + v[j].y * w.y) + (v[j].z * w.z + v[j].w * w.w); }
            ga[gi] = a; }
        float tot = 0.f;
#pragma unroll
        for (int gi = 0; gi < 8; ++gi) { const float t = wave_sum(ga[gi]); tot = ((F.lane >> 3) == gi) ? t : tot; }
        if ((F.lane & 7) == 0) WSP(float, MS_GATES)[(size_t)m * 8 + (F.lane >> 3)] = tot + bg;
    }
}

__device__ __forceinline__ void p4_router(Frame& F) {
    constexpr int RB = 528;
    LAS unsigned char* Bh = F.lds; LAS unsigned char* Bl = F.lds + 48 * RB; LAS unsigned char* Aw = F.lds + 51200 + F.wave * (16 * RB);
    LAS int* hist = (LAS int*)(F.lds + RING_BYTES);
    LAS float* lg = (LAS float*)Aw;
    if (F.tid < 32) hist[F.tid] = 0;
    const int lane = F.lane, fr = lane & 15, fq = lane >> 4;
    const int m0 = F.wg * 128 + F.wave * 16;
    const bf16* HB = WSP(bf16, WS_HB) + (size_t)m0 * D; const bf16* WH = WSP(bf16, MS_WRH); const bf16* WL = WSP(bf16, MS_WRL);
    u32x4 ra[8], rh[3], rl[3];
#define RT_LOAD(ch) do { _Pragma("unroll") for (int i = 0; i < 8; ++i) { const int p_ = lane + 64 * i; ra[i] = *(const u32x4*)(HB + (size_t)(p_ >> 5) * D + 256 * (ch) + (p_ & 31) * 8); } \
        _Pragma("unroll") for (int i = 0; i < 3; ++i) { const int p_ = F.tid + NTHR * i; rh[i] = *(const u32x4*)(WH + (p_ >> 5) * 1024 + 256 * (ch) + (p_ & 31) * 8); rl[i] = *(const u32x4*)(WL + (p_ >> 5) * 1024 + 256 * (ch) + (p_ & 31) * 8); } } while (0)
#define RT_STORE() do { _Pragma("unroll") for (int i = 0; i < 8; ++i) { const int p_ = lane + 64 * i; *(LAS u32x4*)(Aw + (p_ >> 5) * RB + (p_ & 31) * 16) = ra[i]; } \
        _Pragma("unroll") for (int i = 0; i < 3; ++i) { const int p_ = F.tid + NTHR * i; *(LAS u32x4*)(Bh + (p_ >> 5) * RB + (p_ & 31) * 16) = rh[i]; *(LAS u32x4*)(Bl + (p_ >> 5) * RB + (p_ & 31) * 16) = rl[i]; } } while (0)
    RT_LOAD(0);
    f32x4 acc[3]; float ss = 0.f;
#pragma unroll
    for (int n = 0; n < 3; ++n) acc[n] = (f32x4){0.f, 0.f, 0.f, 0.f};
    for (int ch = 0; ch < 4; ++ch) {
        __syncthreads();
        RT_STORE();
        __syncthreads();
        if (ch + 1 < 4) RT_LOAD(ch + 1);
#pragma unroll
        for (int kk = 0; kk < 8; ++kk) { const bf16x8 a = *(const LAS bf16x8*)(Aw + fr * RB + (32 * kk + 8 * fq) * 2); const u32x4 aw = __builtin_bit_cast(u32x4, a);
#pragma unroll
            for (int i = 0; i < 4; ++i) { const float x = bflo(aw[i]), y = bfhi(aw[i]); ss += x * x + y * y; }
#pragma unroll
            for (int n = 0; n < 3; ++n) { const bf16x8 wh = *(const LAS bf16x8*)(Bh + (16 * n + fr) * RB + (32 * kk + 8 * fq) * 2), wl = *(const LAS bf16x8*)(Bl + (16 * n + fr) * RB + (32 * kk + 8 * fq) * 2);
                acc[n] = MFMA16(a, wh, acc[n]); acc[n] = MFMA16(a, wl, acc[n]); } }
    }
#undef RT_LOAD
#undef RT_STORE
    ss += __shfl_xor(ss, 16); ss += __shfl_xor(ss, 32);
    const float rr = rsqrtf(ss * (1.f / D) + EPS);
    if (fq == 0) WSP(float, MS_R1)[m0 + fr] = rr;
    __syncthreads();
#pragma unroll
    for (int r = 0; r < 4; ++r) { const float rrow = __shfl(rr, 4 * fq + r);
#pragma unroll
        for (int n = 0; n < 3; ++n) { const int col = 16 * n + fr; const float bias = (col < 4) ? F.in[11][col] : ((col < 36) ? F.in[13][col - 4] : 0.f);
            lg[(4 * fq + r) * 48 + col] = acc[n][r] * rrow + bias; } }
    LDS_WAIT();
    if (lane < 16) {
        const int m = m0 + lane; const LAS float* row = lg + lane * 48;
        float gl[4];
#pragma unroll
        for (int q = 0; q < 4; ++q) gl[q] = row[q];
        int gs = 0; float gm = gl[0];
#pragma unroll
        for (int q = 1; q < 4; ++q) if (gl[q] > gm) { gm = gl[q]; gs = q; }
        float den = 0.f;
#pragma unroll
        for (int q = 0; q < 4; ++q) den += __expf(gl[q] - gm);
        const float pg = 1.f / den;
        float el[8];
#pragma unroll
        for (int q = 0; q < 8; ++q) el[q] = row[4 + gs * 8 + q];
        int i0 = 0; float v0 = el[0];
#pragma unroll
        for (int q = 1; q < 8; ++q) if (el[q] > v0) { v0 = el[q]; i0 = q; }
        int i1 = -1; float v1 = -3.0e38f;
#pragma unroll
        for (int q = 0; q < 8; ++q) if (q != i0 && el[q] > v1) { v1 = el[q]; i1 = q; }
        const float e1 = __expf(v1 - v0), w0 = pg / (1.f + e1), w1 = pg * e1 / (1.f + e1);
        const int ea = gs * 8 + i0, eb = gs * 8 + i1;
        WSP(int, MS_RE)[2 * m] = ea; WSP(int, MS_RE)[2 * m + 1] = eb;
        WSP(float, MS_RW)[2 * m] = w0; WSP(float, MS_RW)[2 * m + 1] = w1;
        atomicAdd((int*)&hist[ea], 1); atomicAdd((int*)&hist[eb], 1);
    }
    __syncthreads();
    if (F.tid < 32) WSP(int, MS_CNT)[F.wg * 32 + F.tid] = hist[F.tid];
}

__device__ __forceinline__ void p5_scatter(Frame& F) {
    LAS int* base = (LAS int*)(F.lds);
    LAS int* tot = base + 32;
    LAS int* poff = base + 64;
    LAS int* arr = base + 128;
    LAS int* dst = base + 384;
    const int* cnt = WSP(int, MS_CNT);
    if (F.tid < 64) base[F.tid] = 0;
    __syncthreads();
    { const int e = F.tid & 31, part = F.tid >> 5; int t = 0, b = 0;
#pragma unroll
      for (int j = 0; j < 16; ++j) { const int w = part * 16 + j; const int c = cnt[w * 32 + e]; t += c; b += (w < F.wg) ? c : 0; }
      atomicAdd((int*)&tot[e], t); atomicAdd((int*)&base[e], b); }
    __syncthreads();
    if (F.tid == 0) { int o = 0; for (int e = 0; e < 32; ++e) { poff[e] = o; o += (tot[e] + 255) & ~255; } poff[32] = o; }
    __syncthreads();
    if (F.tid < 32) base[F.tid] += poff[F.tid];
    if (F.tid < 256) arr[F.tid] = WSP(int, MS_RE)[F.wg * 256 + F.tid];
    __syncthreads();
    if (F.tid < 256) { const int e = arr[F.tid]; int rk = 0; for (int j = 0; j < F.tid; ++j) rk += (arr[j] == e) ? 1 : 0;
        const int d = base[e] + rk; dst[F.tid] = d; WSP(int, MS_POS)[F.wg * 256 + F.tid] = d; WSP(float, MS_ROWW)[d] = WSP(float, MS_RW)[F.wg * 256 + F.tid];
        WSP(float, MS_ROWR)[d] = WSP(float, MS_R1)[F.wg * 128 + (F.tid >> 1)]; WSP(int, MS_ROWTOK)[d] = F.wg * 128 + (F.tid >> 1); }
    __syncthreads();
    if (F.wg < 32) { const int e = F.wg, r0 = poff[e] + tot[e], r1 = poff[e + 1];
        for (int r = r0 + F.tid; r < r1; r += NTHR) { WSP(float, MS_ROWW)[r] = 0.f; WSP(float, MS_ROWR)[r] = 0.f; WSP(int, MS_ROWTOK)[r] = 0; } }
    if (F.wg == 0) { int* pane = WSP(int, MS_PANE); const int np = poff[32] >> 8; if (F.tid == 0) pane[0] = np;
        for (int p = F.tid; p < np; p += NTHR) { int e = 0; for (int q = 1; q < 32; ++q) e += (p * 256 >= poff[q]) ? 1 : 0; pane[1 + p] = e; } }
    __syncthreads();
}

template <bool MOE>
__device__ __forceinline__ void p8_rows(Frame& F) {
    const int gw = F.wg * NWAVES + F.wave, NGW = F.G * NWAVES;
    bf16* HB = WSP(bf16, WS_HB); const int* POS = WSP(int, MS_POS); const unsigned char* Y = WSP(unsigned char, WS_XIN);
    u32x2 nh[4]; unsigned na[4], nb[4]; int np0 = 0, np1 = 0;
    { const int m = gw;
      if (MOE) { np0 = POS[2 * m]; np1 = POS[2 * m + 1]; }
#pragma unroll
      for (int j = 0; j < 4; ++j) { nh[j] = ((const u32x2*)(HB + (size_t)m * D) + F.lane)[64 * j];
          if (MOE) { na[j] = ((const unsigned*)(Y + (size_t)np0 * D) + F.lane)[64 * j]; nb[j] = ((const unsigned*)(Y + (size_t)np1 * D) + F.lane)[64 * j]; } }
      if (MOE && m + NGW < T) { np0 = POS[2 * (m + NGW)]; np1 = POS[2 * (m + NGW) + 1]; } }
    for (int m = gw; m < T; m += NGW) {
        u32x2 ch[4]; unsigned ca[4], cb[4];
#pragma unroll
        for (int j = 0; j < 4; ++j) { ch[j] = nh[j]; ca[j] = na[j]; cb[j] = nb[j]; }
        const int mn = m + NGW;
        if (mn < T) {
#pragma unroll
            for (int j = 0; j < 4; ++j) { nh[j] = ((const u32x2*)(HB + (size_t)mn * D) + F.lane)[64 * j];
                if (MOE) { na[j] = ((const unsigned*)(Y + (size_t)np0 * D) + F.lane)[64 * j]; nb[j] = ((const unsigned*)(Y + (size_t)np1 * D) + F.lane)[64 * j]; } }
            if (MOE && mn + NGW < T) { np0 = POS[2 * (mn + NGW)]; np1 = POS[2 * (mn + NGW) + 1]; } }
        f32x4 v[4]; float s = 0.f;
#pragma unroll
        for (int j = 0; j < 4; ++j) v[j] = (f32x4){bflo(ch[j].x), bfhi(ch[j].x), bflo(ch[j].y), bfhi(ch[j].y)};
        if (MOE) {
            u32x2* xr = (u32x2*)(HB + (size_t)m * D) + F.lane;
#pragma unroll
            for (int j = 0; j < 4; ++j) { const f32x2 a0 = __builtin_amdgcn_cvt_pk_f32_fp8((int)ca[j], false), a1 = __builtin_amdgcn_cvt_pk_f32_fp8((int)ca[j], true);
                const f32x2 b0 = __builtin_amdgcn_cvt_pk_f32_fp8((int)cb[j], false), b1 = __builtin_amdgcn_cvt_pk_f32_fp8((int)cb[j], true);
                v[j].x += (a0.x + b0.x) * (1.f / S8_Y); v[j].y += (a0.y + b0.y) * (1.f / S8_Y); v[j].z += (a1.x + b1.x) * (1.f / S8_Y); v[j].w += (a1.y + b1.y) * (1.f / S8_Y); }
#pragma unroll
            for (int j = 0; j < 4; ++j) { u32x2 o; o.x = pk2(v[j].x, v[j].y); o.y = pk2(v[j].z, v[j].w); xr[64 * j] = o; }
        }
        { unsigned* q8 = (unsigned*)(WSP(unsigned char, WS_H2Q) + (size_t)m * D) + F.lane;
#pragma unroll
          for (int j = 0; j < 4; ++j) q8[64 * j] = pk4_fp8(v[j].x * S8_H1, v[j].y * S8_H1, v[j].z * S8_H1, v[j].w * S8_H1); }
#pragma unroll
        for (int j = 0; j < 4; ++j) s += (v[j].x * v[j].x + v[j].y * v[j].y) + (v[j].z * v[j].z + v[j].w * v[j].w);
        const float r = rsqrtf(wave_sum(s) * (1.f / D) + EPS);
        if (F.lane == 0) WSP(float, MS_R2)[m] = r;
    }
}

__device__ __forceinline__ void p10_rows(Frame& F) {
    const int gw = F.wg * NWAVES + F.wave, NGW = F.G * NWAVES;
    f32x4 gp[4], gf[4];
#pragma unroll
    for (int j = 0; j < 4; ++j) { gp[j] = ((const f32x4*)F.in[20])[F.lane + 64 * j]; gf[j] = ((const f32x4*)F.in[21])[F.lane + 64 * j]; }
    const bf16* HB = WSP(bf16, WS_HB); const bf16* PB = WSP(bf16, WS_A64); const bf16* GB = WSP(bf16, WS_G);
    u32x2 nh[4], np[4], ng[4];
#pragma unroll
    for (int j = 0; j < 4; ++j) { nh[j] = ((const u32x2*)(HB + (size_t)gw * D) + F.lane)[64 * j]; np[j] = ((const u32x2*)(PB + (size_t)gw * D) + F.lane)[64 * j]; ng[j] = ((const u32x2*)(GB + (size_t)gw * D) + F.lane)[64 * j]; }
    for (int m = gw; m < T; m += NGW) {
        f32x4 h[4], pv[4], gv[4]; float s = 0.f;
#pragma unroll
        for (int j = 0; j < 4; ++j) { const u32x2 hh = nh[j], a = np[j], b = ng[j]; h[j] = (f32x4){bflo(hh.x), bfhi(hh.x), bflo(hh.y), bfhi(hh.y)};
            pv[j] = (f32x4){bflo(a.x), bfhi(a.x), bflo(a.y), bfhi(a.y)}; gv[j] = (f32x4){sigmoidf_(bflo(b.x)), sigmoidf_(bfhi(b.x)), sigmoidf_(bflo(b.y)), sigmoidf_(bfhi(b.y))}; }
        const int mn = m + NGW;
        if (mn < T) {
#pragma unroll
            for (int j = 0; j < 4; ++j) { nh[j] = ((const u32x2*)(HB + (size_t)mn * D) + F.lane)[64 * j]; np[j] = ((const u32x2*)(PB + (size_t)mn * D) + F.lane)[64 * j]; ng[j] = ((const u32x2*)(GB + (size_t)mn * D) + F.lane)[64 * j]; } }
#pragma unroll
        for (int j = 0; j < 4; ++j) s += (pv[j].x * pv[j].x + pv[j].y * pv[j].y) + (pv[j].z * pv[j].z + pv[j].w * pv[j].w);
        const float r = rsqrtf(wave_sum(s) * (1.f / D) + EPS);
        float s2 = 0.f;
#pragma unroll
        for (int j = 0; j < 4; ++j) { h[j] = h[j] + gv[j] * (pv[j] * r * gp[j]); s2 += (h[j].x * h[j].x + h[j].y * h[j].y) + (h[j].z * h[j].z + h[j].w * h[j].w); }
        const float r2 = rsqrtf(wave_sum(s2) * (1.f / D) + EPS);
        f32x4* xr = (f32x4*)(F.out + (size_t)m * D) + F.lane;
#pragma unroll
        for (int j = 0; j < 4; ++j) __builtin_nontemporal_store(h[j] * r2 * gf[j], &xr[64 * j]);
    }
}

constexpr int ML_RAWK = 0, ML_RAWQ = 17408, ML_KT = 34816, ML_VT = 53248, ML_QIMG = 71680, ML_KIMG = 89088, ML_SM = 106496;
constexpr int KT_LD = 72, IMG_LD = 136;

__device__ __forceinline__ float wave_scan_add(float v, int lane) {
#pragma unroll
    for (int o = 1; o < 64; o <<= 1) { const float t = __shfl_up(v, o); v += (lane >= o) ? t : 0.f; }
    return v;
}
__device__ __forceinline__ float wave_scan_max(float v, int lane) {
#pragma unroll
    for (int o = 1; o < 64; o <<= 1) { const float t = __shfl_up(v, o); v = (lane >= o) ? fmaxf(v, t) : v; }
    return v;
}
__device__ __forceinline__ void ml_conv2x8(const LAS bf16* raw, int s, int d0, const LAS float* wbase, float scale, float (&o0)[8], float (&o1)[8]) {
    u32x4 r[5];
#pragma unroll
    for (int j = 0; j < 5; ++j) r[j] = *(const LAS u32x4*)(raw + (s + j) * 128 + d0);
    float a0[8], a1[8];
#pragma unroll
    for (int i = 0; i < 8; ++i) { a0[i] = 0.f; a1[i] = 0.f; }
#pragma unroll
    for (int j = 0; j < 4; ++j) { const f32x4 wa = *(const LAS f32x4*)(wbase + j * 128), wb = *(const LAS f32x4*)(wbase + j * 128 + 4);
        const float w[8] = {wa[0], wa[1], wa[2], wa[3], wb[0], wb[1], wb[2], wb[3]};
#pragma unroll
        for (int i = 0; i < 4; ++i) { const unsigned x0 = r[j][i], x1 = r[j + 1][i];
            a0[2 * i] += bflo(x0) * w[2 * i]; a0[2 * i + 1] += bfhi(x0) * w[2 * i + 1]; a1[2 * i] += bflo(x1) * w[2 * i]; a1[2 * i + 1] += bfhi(x1) * w[2 * i + 1]; } }
#pragma unroll
    for (int i = 0; i < 8; ++i) { o0[i] = siluf_(a0[i]) * scale; o1[i] = siluf_(a1[i]) * scale; }
}
constexpr int AT_LDB = 144;
__device__ __forceinline__ s16x4 lds_tr_read(unsigned addr) { s16x4 r; asm volatile("ds_read_b64_tr_b16 %0, %1" : "=&v"(r) : "v"(addr) : "memory"); return r; }
__device__ __forceinline__ void p2d_attention(Frame& F, int w0, int nw) {
    LAS unsigned char* vl = F.lds + F.wave * 15360;
    LAS unsigned char* kl = vl + 5120; LAS unsigned char* ql = vl + 10240;
    const bf16* U = WSP(bf16, WS_U); bf16* MX = WSP(bf16, WS_A64);
    const int lane = F.lane, fr = lane & 15, fq = lane >> 4;
    const int gw = F.wg * nw + (F.wave - w0), NGW = F.G * nw;
    constexpr float SCL = 0.125f * 1.4426950408889634f;
    const unsigned tra = (unsigned)(size_t)(vl + (4 * fq + (fr >> 2)) * AT_LDB + (fr & 3) * 8);
    for (int task = gw; task < 8192; task += NGW) {
        const int bh = task >> 8, tt = task & 255, b = bh >> 3, h = bh & 7, t0 = tt * 32;
        const size_t hb = (size_t)(h >> 1) * UGS + (size_t)b * SEQ * 128 + (h & 1) * 64;
        const bf16* uq = U + GSQ * UGS + hb; const bf16* uk = U + GSK * UGS + hb; const bf16* uv = U + GSV * UGS + hb;
        bf16x8 qf[2][2];
        { u32x4 qc[4];
#pragma unroll
          for (int i = 0; i < 4; ++i) { const int ch = lane + 64 * i; qc[i] = *(const u32x4*)(uq + (size_t)(t0 + (ch >> 3)) * 128 + (ch & 7) * 8); }
#pragma unroll
          for (int i = 0; i < 4; ++i) { const int ch = lane + 64 * i; *(LAS u32x4*)(ql + (ch >> 3) * AT_LDB + (ch & 7) * 16) = qc[i]; }
          LDS_WAIT();
#pragma unroll
          for (int u = 0; u < 2; ++u)
#pragma unroll
              for (int kk = 0; kk < 2; ++kk) qf[u][kk] = *(const LAS bf16x8*)(ql + (16 * u + fr) * AT_LDB + (32 * kk + 8 * fq) * 2); }
        f32x4 ao[2][4];
#pragma unroll
        for (int u = 0; u < 2; ++u)
#pragma unroll
            for (int n = 0; n < 4; ++n) ao[u][n] = (f32x4){0.f, 0.f, 0.f, 0.f};
        float carry[2] = {0.f, 0.f};
        u32x4 vc[4], kc[4];
#pragma unroll
        for (int i = 0; i < 4; ++i) { const int ch = lane + 64 * i; kc[i] = *(const u32x4*)(uk + (size_t)(t0 + (ch >> 3)) * 128 + (ch & 7) * 8); vc[i] = *(const u32x4*)(uv + (size_t)(t0 + (ch >> 3)) * 128 + (ch & 7) * 8); }
        for (int s0 = t0; s0 >= 0; s0 -= 32) {
            bf16x8 kf[2][2];
#pragma unroll
            for (int i = 0; i < 4; ++i) { const int ch = lane + 64 * i; *(LAS u32x4*)(kl + (ch >> 3) * AT_LDB + (ch & 7) * 16) = kc[i]; }
#pragma unroll
            for (int i = 0; i < 4; ++i) { const int ch = lane + 64 * i; *(LAS u32x4*)(vl + (ch >> 3) * AT_LDB + (ch & 7) * 16) = vc[i]; }
            LDS_WAIT();
#pragma unroll
            for (int ms = 0; ms < 2; ++ms)
#pragma unroll
                for (int kk = 0; kk < 2; ++kk) kf[ms][kk] = *(const LAS bf16x8*)(kl + (16 * ms + fr) * AT_LDB + (32 * kk + 8 * fq) * 2);
            bf16x8 pa[2];
#pragma unroll
            for (int u = 0; u < 2; ++u) {
                const int t = t0 + 16 * u + fr;
                f32x4 z[2];
#pragma unroll
                for (int ms = 0; ms < 2; ++ms) { z[ms] = (f32x4){0.f, 0.f, 0.f, 0.f}; z[ms] = MFMA16(kf[ms][0], qf[u][0], z[ms]); z[ms] = MFMA16(kf[ms][1], qf[u][1], z[ms]); }
                float sp[2][4], g[2];
#pragma unroll
                for (int ms = 0; ms < 2; ++ms) { g[ms] = 0.f;
#pragma unroll
                    for (int r = 0; r < 4; ++r) { const int s = s0 + 16 * ms + 4 * fq + r; const float z2 = z[ms][r] * SCL; z[ms][r] = z2;
                        const float l = __builtin_amdgcn_logf(1.f + __builtin_amdgcn_exp2f(-fabsf(z2))); const float v = (s < t) ? fmaxf(z2, 0.f) + l : 0.f; sp[ms][r] = v; g[ms] += v; } }
                float S0 = g[1], S1 = 0.f, tot = g[0] + g[1];
#pragma unroll
                for (int x = 1; x < 4; ++x) { const float o0 = __shfl_xor(g[0], 16 * x), o1 = __shfl_xor(g[1], 16 * x); const bool later = (fq ^ x) > fq;
                    S0 += o1 + (later ? o0 : 0.f); S1 += later ? o1 : 0.f; tot += o0 + o1; }
                float p[2][4];
#pragma unroll
                for (int ms = 0; ms < 2; ++ms) { float cs = carry[u] + (ms == 0 ? S0 : S1);
#pragma unroll
                    for (int r = 3; r >= 0; --r) { cs += sp[ms][r]; const int s = s0 + 16 * ms + 4 * fq + r; p[ms][r] = (s < t) ? __builtin_amdgcn_exp2f(z[ms][r] - cs) : 0.f; } }
                carry[u] += tot;
                u32x4 pw; pw.x = pk2(p[0][0], p[0][1]); pw.y = pk2(p[0][2], p[0][3]); pw.z = pk2(p[1][0], p[1][1]); pw.w = pk2(p[1][2], p[1][3]);
                pa[u] = __builtin_bit_cast(bf16x8, pw);
            }
            const bool more = (s0 >= 32) && !__all(carry[0] > 64.f && carry[1] > 64.f);
            if (more) {
#pragma unroll
                for (int i = 0; i < 4; ++i) { const int ch = lane + 64 * i; kc[i] = *(const u32x4*)(uk + (size_t)(s0 - 32 + (ch >> 3)) * 128 + (ch & 7) * 8); vc[i] = *(const u32x4*)(uv + (size_t)(s0 - 32 + (ch >> 3)) * 128 + (ch & 7) * 8); } }
            s16x4 vlo[4], vhi[4];
#pragma unroll
            for (int n = 0; n < 4; ++n) { vlo[n] = lds_tr_read(tra + n * 32); vhi[n] = lds_tr_read(tra + n * 32 + 16 * AT_LDB); }
            LDS_WAIT(); __builtin_amdgcn_sched_barrier(0);
#pragma unroll
            for (int n = 0; n < 4; ++n) { bf16x8 vb; vb[0] = vlo[n][0]; vb[1] = vlo[n][1]; vb[2] = vlo[n][2]; vb[3] = vlo[n][3]; vb[4] = vhi[n][0]; vb[5] = vhi[n][1]; vb[6] = vhi[n][2]; vb[7] = vhi[n][3];
                ao[0][n] = MFMA16(vb, pa[0], ao[0][n]); ao[1][n] = MFMA16(vb, pa[1], ao[1][n]); }
            if (!more) break;
        }
#pragma unroll
        for (int u = 0; u < 2; ++u)
#pragma unroll
            for (int n = 0; n < 4; ++n) { u32x2 o; o.x = pk2(ao[u][n][0], ao[u][n][1]); o.y = pk2(ao[u][n][2], ao[u][n][3]);
                *(u32x2*)(MX + ((size_t)b * SEQ + t0 + 16 * u + fr) * D + 512 + h * 64 + 16 * n + 4 * fq) = o; }
    }
}

constexpr int NSC = 16, SCR = 512;
constexpr int FM_RAWQ = 0, FM_RAWK = 17408, FM_QI = 34816, FM_KI = 52224, FM_KE = 69632, FM_VI = 87040, FM_CT = 104448, FM_SM = 139264;
constexpr int IB = 272;
struct FmRegs { u32x4 k0, k1, q0, q1, v0, v1, hh, o0, o1; f32x4 gs; float ml, bl; };
template <bool WITH_Q, int HT0 = 0, bool HALO = true>
__device__ __forceinline__ void fm_load(Frame& F, FmRegs& R, int b, int h, int c  ) {
    const bf16* U = WSP(bf16, WS_U); const float* gates = WSP(float, MS_GATES);
    const size_t rb = ((size_t)b * SEQ + c * 64) * 128;
    const bf16* uq = U + (GQ + h) * UGS + rb; const bf16* uk = U + (GK + h) * UGS + rb; const bf16* uv = U + (GV + h) * UGS + rb;
    const int r0 = F.tid >> 4, cc = F.tid & 15;
#define FM_LD(p_) (*(const u32x4*)(p_))
    R.k0 = FM_LD(uk + r0 * 128 + cc * 8); R.k1 = FM_LD(uk + (r0 + 32) * 128 + cc * 8);
    if (WITH_Q) { R.q0 = FM_LD(uq + r0 * 128 + cc * 8); R.q1 = FM_LD(uq + (r0 + 32) * 128 + cc * 8); }
    R.v0 = FM_LD(uv + r0 * 128 + cc * 8); R.v1 = FM_LD(uv + (r0 + 32) * 128 + cc * 8);
    if (WITH_Q) { const bf16* uo = U + (GO + h) * UGS + rb; R.o0 = FM_LD(uo + r0 * 128 + cc * 8); R.o1 = FM_LD(uo + (r0 + 32) * 128 + cc * 8); }
#undef FM_LD
    R.hh = (u32x4){0u, 0u, 0u, 0u};
    { const int th = F.tid - HT0;
      if (HALO && th >= 0 && th < (WITH_Q ? 96 : 48) && c > 0) { const int isq = th >= 48, x = th - (isq ? 48 : 0), hr = x >> 4, hc = x & 15;
        R.hh = *(const u32x4*)((isq ? uq : uk) + (ptrdiff_t)(hr - 3) * 128 + hc * 8); } }
    R.gs = (f32x4){0.f, 0.f, 0.f, 0.f}; R.ml = 0.f; R.bl = 0.f;
    if (WITH_Q && F.tid < 64) { const size_t row = (size_t)b * SEQ + c * 64 + F.tid; R.gs = *(const f32x4*)(WSP(float, MS_GS) + (row * 4 + h) * 4);
        const float* chp = WSP(float, MS_CH) + ((size_t)(b * NCH + c) * 4 + h) * 2; R.ml = chp[0]; R.bl = chp[1]; }
}
template <bool WITH_Q, int HT0 = 0, bool HALO = true>
__device__ __forceinline__ void fm_store(Frame& F, const FmRegs& R) {
    const int r0 = F.tid >> 4, cc = F.tid & 15;
    *(LAS u32x4*)(F.lds + FM_RAWK + (r0 + 3) * 256 + cc * 16) = R.k0; *(LAS u32x4*)(F.lds + FM_RAWK + (r0 + 35) * 256 + cc * 16) = R.k1;
    if (WITH_Q) { *(LAS u32x4*)(F.lds + FM_RAWQ + (r0 + 3) * 256 + cc * 16) = R.q0; *(LAS u32x4*)(F.lds + FM_RAWQ + (r0 + 35) * 256 + cc * 16) = R.q1; }
    *(LAS u32x4*)(F.lds + FM_VI + r0 * IB + cc * 16) = R.v0; *(LAS u32x4*)(F.lds + FM_VI + (r0 + 32) * IB + cc * 16) = R.v1;
    { const int th = F.tid - HT0;
      if (HALO && th >= 0 && th < (WITH_Q ? 96 : 48)) { const int isq = th >= 48, x = th - (isq ? 48 : 0); *(LAS u32x4*)(F.lds + (isq ? FM_RAWQ : FM_RAWK) + (x >> 4) * 256 + (x & 15) * 16) = R.hh; } }
}
struct TrPair { s16x4 lo, hi; };
__device__ __forceinline__ TrPair fm_tr_issue(unsigned base, const int off0, const int off1) {
    TrPair p;
    asm volatile("ds_read_b64_tr_b16 %0, %1 offset:%2" : "=&v"(p.lo) : "v"(base), "i"(off0) : "memory");
    asm volatile("ds_read_b64_tr_b16 %0, %1 offset:%2" : "=&v"(p.hi) : "v"(base), "i"(off1) : "memory");
    return p;
}
__device__ __forceinline__ bf16x8 fm_tr_get(const TrPair& p) { bf16x8 r; r[0] = p.lo[0]; r[1] = p.lo[1]; r[2] = p.lo[2]; r[3] = p.lo[3]; r[4] = p.hi[0]; r[5] = p.hi[1]; r[6] = p.hi[2]; r[7] = p.hi[3]; return r; }
#define TR_WAIT() do { asm volatile("s_waitcnt lgkmcnt(0)" ::: "memory"); __builtin_amdgcn_sched_barrier(0); } while (0)
__device__ __forceinline__ void p2a_super(Frame& F) {
    LAS bf16* rawk = (LAS bf16*)(F.lds + FM_RAWK);
    LAS float* s_e = (LAS float*)(F.lds + FM_CT);
    LAS float* s_x = (LAS float*)(F.lds + FM_SM + 2304);
    LAS float* cw = (LAS float*)(F.lds + FM_SM + 2560);
    const int lane = F.lane, w = F.wave, fr = lane & 15, fq = lane >> 4;
    const int it = F.wg, bh = it >> 4, sc = it & 15, b = bh >> 2, h = bh & 3;
    const float* gates = WSP(float, MS_GATES);
    for (int i = F.tid; i < 1024; i += NTHR) { const int qk = i >> 9, j = (i >> 7) & 3, d = i & 127; cw[i] = F.in[qk ? 6 : 5][j * 512 + h * 128 + d]; }
    FmRegs R; fm_load<false>(F, R, b, h, sc * 8);
    float e_mine;
    { const size_t row = (size_t)b * SEQ + sc * SCR + 64 * w + lane; const float ip = gates[row * 8 + h], fp = gates[row * 8 + 4 + h];
      float bb = wave_scan_add(log_sigmoidf_(fp), lane);
      {
        const float blc = __shfl(bb, 63), wec = blc - bb + ip, mlc = wave_max(wec), pmc = wave_scan_max(ip - bb, lane);
        *(f32x4*)(WSP(float, MS_GS) + (row * 4 + h) * 4) = (f32x4){bb, ip, __expf(wec - mlc), pmc};
        if (lane == 0) { float* chp = WSP(float, MS_CH) + ((size_t)(b * NCH + sc * 8 + w) * 4 + h) * 2; chp[0] = mlc; chp[1] = blc; } }
      if (lane == 63) s_x[w] = bb;
      __syncthreads();
      float off = 0.f, tot = 0.f;
#pragma unroll
      for (int j = 0; j < 8; ++j) { const float t = s_x[j]; off += (j < w) ? t : 0.f; tot += t; }
      bb += off;
      const float we = tot - bb + ip; const float mw = wave_max(we);
      if (lane == 0) s_x[8 + w] = mw;
      __syncthreads();
      float ml = s_x[8];
#pragma unroll
      for (int j = 1; j < 8; ++j) ml = fmaxf(ml, s_x[8 + j]);
      e_mine = __expf(we - ml);
      s_e[64 * w + lane] = e_mine;
      if (F.tid == 0) { WSP(float, MS_MLOC)[it] = ml; WSP(float, MS_BLAST)[it] = tot; } }
    f32x4 acc[8];
#pragma unroll
    for (int n = 0; n < 8; ++n) acc[n] = (f32x4){0.f, 0.f, 0.f, 0.f};
    f32x4 dnv = (f32x4){0.f, 0.f, 0.f, 0.f};
    bf16x8 ones;
#pragma unroll
    for (int i = 0; i < 8; ++i) ones[i] = (short)0x3F80;
    const unsigned tra = (unsigned)(size_t)(F.lds + FM_KE + (8 * fq + (fr >> 2)) * IB + (16 * w + 4 * (fr & 3)) * 2);
    const unsigned trb = (unsigned)(size_t)(F.lds + FM_VI + (8 * fq + (fr >> 2)) * IB + (4 * (fr & 3)) * 2);
    for (int j = 0; j < 8; ++j) {
        fm_store<false>(F, R);
        __syncthreads();
        if (j + 1 < 8) fm_load<false>(F, R, b, h, sc * 8 + j + 1);
        { const int sp = F.tid >> 4, dg = F.tid & 15, s = 2 * sp, d0 = 8 * dg; float o0[8], o1[8];
          ml_conv2x8(rawk, s, d0, cw + 512 + d0, 0.08838834764831845f, o0, o1);
          const float e0 = s_e[64 * j + s], e1 = s_e[64 * j + s + 1];
          u32x4 x; x.x = pk2(o0[0] * e0, o0[1] * e0); x.y = pk2(o0[2] * e0, o0[3] * e0); x.z = pk2(o0[4] * e0, o0[5] * e0); x.w = pk2(o0[6] * e0, o0[7] * e0);
          *(LAS u32x4*)(F.lds + FM_KE + s * IB + d0 * 2) = x;
          x.x = pk2(o1[0] * e1, o1[1] * e1); x.y = pk2(o1[2] * e1, o1[3] * e1); x.z = pk2(o1[4] * e1, o1[5] * e1); x.w = pk2(o1[6] * e1, o1[7] * e1);
          *(LAS u32x4*)(F.lds + FM_KE + (s + 1) * IB + d0 * 2) = x; }
        __syncthreads();
#pragma unroll
        for (int kk = 0; kk < 2; ++kk) { const TrPair pa = fm_tr_issue(tra, 32 * kk * IB, (32 * kk + 4) * IB); TrPair pb[8];
#pragma unroll
            for (int n = 0; n < 8; ++n) pb[n] = fm_tr_issue(trb, 32 * kk * IB + 32 * n, (32 * kk + 4) * IB + 32 * n);
            TR_WAIT();
            const bf16x8 a = fm_tr_get(pa);
#pragma unroll
            for (int n = 0; n < 8; ++n) acc[n] = MFMA16(a, fm_tr_get(pb[n]), acc[n]);
            dnv = MFMA16(a, ones, dnv); }
        __syncthreads();
    }
    bf16* Cg = WSP(bf16, WS_C) + (size_t)it * 16384;
#pragma unroll
    for (int n = 0; n < 8; ++n) { u32x2 o; o.x = pk2(acc[n][0], acc[n][1]); o.y = pk2(acc[n][2], acc[n][3]);
        *(u32x2*)(Cg + (16 * n + fr) * 128 + 16 * w + 4 * fq) = o; }
    if (fr == 0) *(f32x4*)(WSP(float, MS_DN) + it * 128 + 16 * w + 4 * fq) = dnv;
}

__device__ __forceinline__ void p2c_fused(Frame& F) {
    LAS bf16* rawq = (LAS bf16*)(F.lds + FM_RAWQ); LAS bf16* rawk = (LAS bf16*)(F.lds + FM_RAWK);
    LAS float* s_b = (LAS float*)(F.lds + FM_SM); LAS float* s_li = s_b + 64; LAS float* s_e = s_b + 128; LAS float* s_mt = s_b + 192; LAS float* s_ai = s_b + 256;
    LAS float* s_n = s_b + 320;
    LAS float* s_x = s_b + 576;
    LAS float* s_ss = s_b + 592;
    LAS float* cw = (LAS float*)(F.lds + FM_SM + 3072);
    const int lane = F.lane, w = F.wave, fr = lane & 15, fq = lane >> 4;
    const int it = F.wg, bh = it >> 4, sc = it & 15, b = bh >> 2, h = bh & 3;
    const bf16* U = WSP(bf16, WS_U); bf16* MX = WSP(bf16, WS_A64);
    for (int i = F.tid; i < 1024; i += NTHR) { const int qk = i >> 9, j = (i >> 7) & 3, d = i & 127; cw[i] = F.in[qk ? 6 : 5][j * 512 + h * 128 + d]; }
    FmRegs R; fm_load<true>(F, R, b, h, sc * 8);
    float m = 0.f;
    { const int row = F.tid >> 2, pc = F.tid & 3; float acc[32], an = 0.f;
#pragma unroll
      for (int i = 0; i < 32; ++i) acc[i] = 0.f;
      const bf16* Cb = WSP(bf16, WS_C) + (size_t)(bh * NSC) * 16384 + row * 128 + pc * 32; const float* DNb = WSP(float, MS_DN) + (size_t)(bh * NSC) * 128 + (F.tid & 127);
      float mlv = 0.f, blv = 0.f;
      if (lane < NSC) { mlv = WSP(float, MS_MLOC)[bh * NSC + lane]; blv = WSP(float, MS_BLAST)[bh * NSC + lane]; }
      for (int p0 = 0; p0 < sc; p0 += 4) {
          u32x4 cv[4][4]; float cd[4];
#pragma unroll
          for (int u = 0; u < 4; ++u) { const int pp = min(p0 + u, sc - 1);
#pragma unroll
              for (int q = 0; q < 4; ++q) cv[u][q] = *(const u32x4*)(Cb + (size_t)pp * 16384 + q * 8);
              cd[u] = DNb[pp * 128]; }
#pragma unroll
          for (int u = 0; u < 4; ++u) { const bool act = p0 + u < sc; const int pl = min(p0 + u, NSC - 1);
              const float ml = __builtin_bit_cast(float, __builtin_amdgcn_readlane(__builtin_bit_cast(int, mlv), pl)), bl = __builtin_bit_cast(float, __builtin_amdgcn_readlane(__builtin_bit_cast(int, blv), pl));
              const float mn = act ? fmaxf(bl + m, ml) : m; const float dec = act ? __expf(bl + m - mn) : 1.f, scl = act ? __expf(ml - mn) : 0.f;
#pragma unroll
              for (int q = 0; q < 4; ++q)
#pragma unroll
                  for (int i = 0; i < 4; ++i) { acc[8 * q + 2 * i] = dec * acc[8 * q + 2 * i] + scl * bflo(cv[u][q][i]); acc[8 * q + 2 * i + 1] = dec * acc[8 * q + 2 * i + 1] + scl * bfhi(cv[u][q][i]); }
              an = dec * an + scl * cd[u]; m = mn; } }
#pragma unroll
      for (int q = 0; q < 4; ++q) { u32x4 o; o.x = pk2(acc[8 * q], acc[8 * q + 1]); o.y = pk2(acc[8 * q + 2], acc[8 * q + 3]); o.z = pk2(acc[8 * q + 4], acc[8 * q + 5]); o.w = pk2(acc[8 * q + 6], acc[8 * q + 7]);
          *(LAS u32x4*)(F.lds + FM_CT + row * IB + (pc * 4 + q) * 16) = o; }
      if (F.tid < 128) s_n[F.tid] = an; }
    __syncthreads();
    f32x4 st[8];
#pragma unroll
    for (int n = 0; n < 8; ++n) { const u32x2 c = *(const LAS u32x2*)(F.lds + FM_CT + (16 * n + fr) * IB + (16 * w + 4 * fq) * 2); st[n] = (f32x4){bflo(c.x), bfhi(c.x), bflo(c.y), bfhi(c.y)}; }
    const int nt = w & 3, eh = w >> 2, tl = 16 * nt + fr;
    bf16x8 ones;
#pragma unroll
    for (int i = 0; i < 8; ++i) ones[i] = (short)0x3F80;
    const unsigned trq = (unsigned)(size_t)(F.lds + (fr >> 2) * IB + (4 * (fr & 3)) * 2);
    const unsigned tr_vo = trq + FM_VI + (4 * fq) * IB + 128 * eh;
    const unsigned tr_ka = trq + FM_KE + (8 * fq) * IB + 32 * w, tr_vb = trq + FM_VI + (8 * fq) * IB;
    for (int j = 0; j < 8; ++j) {
        const int c = sc * 8 + j; const size_t row0 = (size_t)b * SEQ + c * 64;
        fm_store<true>(F, R);
        if (w == 0) {
            s_b[lane] = R.gs[0]; s_li[lane] = R.gs[1]; s_e[lane] = R.gs[2]; s_mt[lane] = R.gs[3];
            if (lane == 0) { s_x[0] = R.ml; s_x[1] = R.bl; }
        }
        __syncthreads();
        const u32x4 co0 = R.o0, co1 = R.o1;
        if (j + 1 < 8) fm_load<true>(F, R, b, h, c + 1);
        const float ml = s_x[0], bl = s_x[1]; const float mn = fmaxf(bl + m, ml); const float dec = __expf(bl + m - mn), scl = __expf(ml - mn);
        { const int sp = F.tid >> 4, dg = F.tid & 15, s = 2 * sp, d0 = 8 * dg; float o0[8], o1[8];
          ml_conv2x8(rawq, s, d0, cw + d0, 1.f, o0, o1);
          u32x4 x; x.x = pk2(o0[0], o0[1]); x.y = pk2(o0[2], o0[3]); x.z = pk2(o0[4], o0[5]); x.w = pk2(o0[6], o0[7]); *(LAS u32x4*)(F.lds + FM_QI + s * IB + d0 * 2) = x;
          x.x = pk2(o1[0], o1[1]); x.y = pk2(o1[2], o1[3]); x.z = pk2(o1[4], o1[5]); x.w = pk2(o1[6], o1[7]); *(LAS u32x4*)(F.lds + FM_QI + (s + 1) * IB + d0 * 2) = x;
          ml_conv2x8(rawk, s, d0, cw + 512 + d0, 0.08838834764831845f, o0, o1);
          x.x = pk2(o0[0], o0[1]); x.y = pk2(o0[2], o0[3]); x.z = pk2(o0[4], o0[5]); x.w = pk2(o0[6], o0[7]); *(LAS u32x4*)(F.lds + FM_KI + s * IB + d0 * 2) = x;
          x.x = pk2(o1[0], o1[1]); x.y = pk2(o1[2], o1[3]); x.z = pk2(o1[4], o1[5]); x.w = pk2(o1[6], o1[7]); *(LAS u32x4*)(F.lds + FM_KI + (s + 1) * IB + d0 * 2) = x;
          const float e0 = s_e[s] * scl, e1 = s_e[s + 1] * scl;
          x.x = pk2(o0[0] * e0, o0[1] * e0); x.y = pk2(o0[2] * e0, o0[3] * e0); x.z = pk2(o0[4] * e0, o0[5] * e0); x.w = pk2(o0[6] * e0, o0[7] * e0); *(LAS u32x4*)(F.lds + FM_KE + s * IB + d0 * 2) = x;
          x.x = pk2(o1[0] * e1, o1[1] * e1); x.y = pk2(o1[2] * e1, o1[3] * e1); x.z = pk2(o1[4] * e1, o1[5] * e1); x.w = pk2(o1[6] * e1, o1[7] * e1); *(LAS u32x4*)(F.lds + FM_KE + (s + 1) * IB + d0 * 2) = x; }
        __syncthreads();
        { const int r0 = F.tid >> 4, cc = F.tid & 15;
          *(LAS u32x4*)(F.lds + FM_RAWQ + r0 * IB + cc * 16) = co0; *(LAS u32x4*)(F.lds + FM_RAWQ + (r0 + 32) * IB + cc * 16) = co1; }
        const LAS float* ncur = s_n + (j & 1) * 128; LAS float* nnew = s_n + ((j + 1) & 1) * 128;
        f32x4 ao[4], ai[4]; float a_i, dd;
        { const float bt = s_b[tl], mtt = bt + fmaxf(m, s_mt[tl]); a_i = __expf(bt + m - mtt);
          bf16x8 qf[4];
#pragma unroll
          for (int kk = 0; kk < 4; ++kk) qf[kk] = *(const LAS bf16x8*)(F.lds + FM_QI + tl * IB + (32 * kk + 8 * fq) * 2);
          f32x4 as[4];
#pragma unroll
          for (int ms = 0; ms < 4; ++ms) { as[ms] = (f32x4){0.f, 0.f, 0.f, 0.f};
#pragma unroll
              for (int kk = 0; kk < 4; ++kk) { const bf16x8 ka = *(const LAS bf16x8*)(F.lds + FM_KI + (16 * ms + fr) * IB + (32 * kk + 8 * fq) * 2); as[ms] = MFMA16(ka, qf[kk], as[ms]); } }
          float qn = 0.f;
#pragma unroll
          for (int kk = 0; kk < 4; ++kk) { const f32x4 n0 = *(const LAS f32x4*)(ncur + 32 * kk + 8 * fq), n1 = *(const LAS f32x4*)(ncur + 32 * kk + 8 * fq + 4); const u32x4 qw = __builtin_bit_cast(u32x4, qf[kk]);
              qn += bflo(qw.x) * n0[0] + bfhi(qw.x) * n0[1] + bflo(qw.y) * n0[2] + bfhi(qw.y) * n0[3] + bflo(qw.z) * n1[0] + bfhi(qw.z) * n1[1] + bflo(qw.w) * n1[2] + bfhi(qw.w) * n1[3]; }
          qn += __shfl_xor(qn, 16); qn += __shfl_xor(qn, 32);
          float dsum = 0.f;
          { f32x4 sbv[4], slv[4];
#pragma unroll
            for (int ms = 0; ms < 4; ++ms) { sbv[ms] = *(const LAS f32x4*)(s_b + 16 * ms + 4 * fq); slv[ms] = *(const LAS f32x4*)(s_li + 16 * ms + 4 * fq); }
#pragma unroll
            for (int ms = 0; ms < 4; ++ms) {
#pragma unroll
              for (int r = 0; r < 4; ++r) { const int s = 16 * ms + 4 * fq + r; const float lw = bt - sbv[ms][r] + slv[ms][r] - mtt;
                  const float ex = __builtin_amdgcn_exp2f(lw * 1.4426950408889634f) * as[ms][r];
                  const float wv = (s <= tl) ? ex : 0.f; as[ms][r] = wv; dsum += wv; } } }
          dsum += __shfl_xor(dsum, 16); dsum += __shfl_xor(dsum, 32);
          const float den = dsum + a_i * qn; dd = 1.f / fmaxf(fabsf(den), __expf(-mtt));
#pragma unroll
          for (int n = 0; n < 4; ++n) { ao[n] = (f32x4){0.f, 0.f, 0.f, 0.f}; ai[n] = (f32x4){0.f, 0.f, 0.f, 0.f}; }
#pragma unroll
          for (int k2 = 0; k2 < 2; ++k2) {
              u32x4 pw; pw.x = pk2(as[2 * k2][0], as[2 * k2][1]); pw.y = pk2(as[2 * k2][2], as[2 * k2][3]); pw.z = pk2(as[2 * k2 + 1][0], as[2 * k2 + 1][1]); pw.w = pk2(as[2 * k2 + 1][2], as[2 * k2 + 1][3]);
              const bf16x8 pb = __builtin_bit_cast(bf16x8, pw);
              TrPair pv[4];
#pragma unroll
              for (int n = 0; n < 4; ++n) pv[n] = fm_tr_issue(tr_vo, 32 * k2 * IB + 32 * n, (32 * k2 + 16) * IB + 32 * n);
              TR_WAIT();
#pragma unroll
              for (int n = 0; n < 4; ++n) ao[n] = MFMA16(fm_tr_get(pv[n]), pb, ao[n]); }
#pragma unroll
          for (int kk = 0; kk < 4; ++kk)
#pragma unroll
              for (int n = 0; n < 4; ++n) { const bf16x8 ca = *(const LAS bf16x8*)(F.lds + FM_CT + (64 * eh + 16 * n + fr) * IB + (32 * kk + 8 * fq) * 2); ai[n] = MFMA16(ca, qf[kk], ai[n]); } }
        float q = 0.f;
#pragma unroll
        for (int n = 0; n < 4; ++n)
#pragma unroll
            for (int r = 0; r < 4; ++r) { const float x = (ao[n][r] + a_i * ai[n][r]) * dd; ao[n][r] = x; q += x * x; }
        q += __shfl_xor(q, 16); q += __shfl_xor(q, 32);
        if (fq == 0) s_ss[eh * 64 + tl] = q;
#pragma unroll
        for (int n = 0; n < 8; ++n) st[n] = st[n] * dec;
        f32x4 sn = (f32x4){0.f, 0.f, 0.f, 0.f};
#pragma unroll
        for (int kk = 0; kk < 2; ++kk) { const TrPair pa = fm_tr_issue(tr_ka, 32 * kk * IB, (32 * kk + 4) * IB); TrPair pb[8];
#pragma unroll
            for (int n = 0; n < 8; ++n) pb[n] = fm_tr_issue(tr_vb, 32 * kk * IB + 32 * n, (32 * kk + 4) * IB + 32 * n);
            TR_WAIT();
            const bf16x8 a = fm_tr_get(pa);
#pragma unroll
            for (int n = 0; n < 8; ++n) st[n] = MFMA16(a, fm_tr_get(pb[n]), st[n]);
            sn = MFMA16(a, ones, sn); }
        if (fr == 0) { const f32x4 nc = *(const LAS f32x4*)(ncur + 16 * w + 4 * fq); *(LAS f32x4*)(nnew + 16 * w + 4 * fq) = nc * dec + sn; }
        __syncthreads();
        { const float rn = rsqrtf((s_ss[tl] + s_ss[64 + tl]) * (1.f / 128.f) + EPS);
#pragma unroll
          for (int n = 0; n < 4; ++n) { const int e0 = h * 128 + 64 * eh + 16 * n + 4 * fq; const f32x4 gh = *(const f32x4*)(F.in[7] + e0);
              const u32x2 mo = *(const LAS u32x2*)(F.lds + FM_RAWQ + tl * IB + (64 * eh + 16 * n + 4 * fq) * 2);
              u32x2 o; o.x = pk2(ao[n][0] * rn * gh[0] * sigmoidf_(bflo(mo.x)), ao[n][1] * rn * gh[1] * sigmoidf_(bfhi(mo.x)));
              o.y = pk2(ao[n][2] * rn * gh[2] * sigmoidf_(bflo(mo.y)), ao[n][3] * rn * gh[3] * sigmoidf_(bfhi(mo.y)));
              *(LAS u32x2*)(F.lds + FM_QI + tl * IB + (64 * eh + 16 * n + 4 * fq) * 2) = o; } }
#pragma unroll
        for (int n = 0; n < 8; ++n) { u32x2 o; o.x = pk2(st[n][0], st[n][1]); o.y = pk2(st[n][2], st[n][3]);
            *(LAS u32x2*)(F.lds + FM_CT + (16 * n + fr) * IB + (16 * w + 4 * fq) * 2) = o; }
        m = mn;
        __syncthreads();
        { const int r0 = F.tid >> 4, cc = F.tid & 15;
          *(u32x4*)(MX + (row0 + r0) * D + h * 128 + cc * 8) = *(const LAS u32x4*)(F.lds + FM_QI + r0 * IB + cc * 16);
          *(u32x4*)(MX + (row0 + r0 + 32) * D + h * 128 + cc * 8) = *(const LAS u32x4*)(F.lds + FM_QI + (r0 + 32) * IB + cc * 16); }
    }
}

#ifndef EN_MIX
#define EN_MIX 1
#endif
#ifndef EN_MOE
#define EN_MOE 1
#endif
constexpr int NPH = 13;
__global__ void __launch_bounds__(NTHR, 2) hymba_fwd(Args args) {
    extern __shared__ __attribute__((aligned(16))) unsigned char lds_raw[];
    Frame F;
    F.lds = (LAS unsigned char*)lds_raw;
    F.tid = threadIdx.x; F.lane = F.tid & 63; F.wave = __builtin_amdgcn_readfirstlane(F.tid >> 6);
    F.G = gridDim.x; F.wg = blockIdx.x; F.in = args.in; F.out = args.out; F.ws = args.ws;
    volatile LAS unsigned* MISC = (volatile LAS unsigned*)(F.lds + MISC_OFF);
    if (F.tid < 32) MISC[F.tid] = 0u;
    __syncthreads();
    const int lo = args.ph_lo, hi = args.ph_hi;
    XcdBarrier bar; bar.bar = (unsigned*)(F.ws + WS_CTL) + CW_BAR; bar.x = 0; bar.st = nullptr;
    if (hi - lo > 1) bar = xcd_barrier_post((unsigned*)(F.ws + WS_CTL) + CW_BAR, MISC + 8);
#define IN(k) (lo <= (k) && (k) < hi)
#define SEAM(k) do { if (IN(k) && IN((k) + 1)) xcd_barrier(bar); } while (0)

    if (IN(0)) { p0_weights(F); p0_rows(F); }
    SEAM(0);
    if (IN(1)) {
        static_assert((P0_JX - P0_JE) % (256 * NWAVES * LB) == 0, "late items per wave");
        const int nk = (P0_JX - P0_JE) / (256 * NWAVES), slot = (F.wg >> 3) & 7;
        pg8::DenseOrder S; S.init(T, NU, 1024, F.G, F.wg, WSP(bf16, WS_A64), WSP(bf16, WS_WIN));
#pragma nounroll
        for (int pass = 0; pass < 3; ++pass) {
            if (pass == 1) { p0_late(F, 0, nk); __syncthreads(); }
            else { S.ioff = pass ? slot : 0; S.icnt = pass ? (1 << 20) : slot;
                pg8::EpiBf16<0> E{WSP(bf16, WS_U), 128, nullptr, 1.f, UGS};
                pg8::gemm_phase<false>(F.lds, 1024, S, E); }
        }
    }
    SEAM(1);
    if (IN(2)) {
#if EN_MIX
        p2a_super(F); __syncthreads(); p2d_attention(F, 0, 8);
#endif
    }
    SEAM(2);
    if (IN(4)) {
#if EN_MIX
        p2c_fused(F);
#endif
    }
    SEAM(4);
    if (IN(5)) {
#if EN_MIX
        const bool pfirst = (F.wg >> 3) & 1;
        if (pfirst) p0_pconv(F);
        { pg8::DenseOrder S; S.init(T, 1024, 1024, F.G, F.wg, WSP(bf16, WS_A64), WSP(bf16, WS_WOUT));
          pg8::EpiResBf16 E{WSP(bf16, WS_HB), F.in[0], WSP(unsigned char, WS_H8)};
          pg8::gemm_phase<false>(F.lds, 1024, S, E); }
        if (!pfirst) p0_pconv(F);
#else
        for (size_t i = (size_t)F.wg * NTHR + F.tid; i < (size_t)T * D / 4; i += (size_t)F.G * NTHR) { const f32x4 a = ((const f32x4*)F.in[0])[i]; u32x2 o; o.x = pk2(a[0], a[1]); o.y = pk2(a[2], a[3]); WSP(u32x2, WS_HB)[i] = o; }
#endif
    }
    SEAM(5);
    if (IN(6)) {
#if EN_MOE
        p4_router(F);
#endif
    }
    SEAM(6);
    if (IN(7)) {
#if EN_MOE
        p5_scatter(F);
#endif
    }
    SEAM(7);
    if (IN(8)) {
#if EN_MOE
        const int* pane = WSP(int, MS_PANE);
        { pg8::MoeOrder S{pane[0] * 4, F.G, F.wg, pane, (const char*)WSP(unsigned char, WS_H8), (const char*)WSP(unsigned char, WS_WGU), 0, (size_t)256 * 1024, (size_t)1024 * 1024, WSP(int, MS_ROWTOK), (LAS int*)(F.lds + RING_BYTES), false, WSP(float, MS_ROWR)};
          S.preload();
          pg8::EpiGateUp E{WSP(unsigned char, WS_HID), WSP(float, MS_ROWR)};
          int k8 = 512; asm volatile("" : "+s"(k8));
          pg8::gemm_phase_fp8<true>(F.lds, k8, S, E); }
        { pg8::FillOrder S{pane[0] * 4, 0, 384, F.G, F.wg, 256, (const char*)WSP(bf16, WS_PB), (const char*)WSP(bf16, WS_WPP)};
          pg8::EpiBf16<0> E{WSP(bf16, WS_A64), 1024, nullptr, 1.f, 0};
          int k2 = 256; asm volatile("" : "+s"(k2));
          pg8::gemm_phase<false>(F.lds, k2, S, E); }
#endif
    }
    SEAM(8);
    if (IN(9)) {
#if EN_MOE
        const int* pane = WSP(int, MS_PANE);
        pg8::MoeOrder S{pane[0] * 4, F.G, F.wg, pane, (const char*)WSP(unsigned char, WS_HID), (const char*)WSP(unsigned char, WS_WD), (size_t)256 * 512, (size_t)256 * 512, (size_t)1024 * 512, nullptr, (LAS int*)(F.lds + RING_BYTES), true, WSP(float, MS_ROWW)};
        S.preload();
        pg8::EpiDown E{WSP(unsigned char, WS_XIN), WSP(float, MS_ROWW)};
        int k8 = 256; asm volatile("" : "+s"(k8));
        pg8::gemm_phase_fp8<true>(F.lds, k8, S, E);
        { pg8::FillOrder S2{pane[0] * 4, 384, 512, F.G, F.wg, 256, (const char*)WSP(bf16, WS_PB), (const char*)WSP(bf16, WS_WPP)};
          pg8::EpiBf16<0> E2{WSP(bf16, WS_A64), 1024, nullptr, 1.f, 0};
          int k2 = 256; asm volatile("" : "+s"(k2));
          pg8::gemm_phase<false>(F.lds, k2, S2, E2); }
#endif
    }
    SEAM(9);
    if (IN(10)) {
#if EN_MOE
        p8_rows<true>(F);
#else
        p8_rows<false>(F);
#endif
    }
    SEAM(10);
    if (IN(11)) {
        { pg8::DenseOrderG<2> S; S.init(T, 1024, 512, F.G, F.wg, WSP(unsigned char, WS_H2Q), WSP(unsigned char, WS_WPG)); S.tbl = (LAS int*)(F.lds + RING_BYTES); S.rowfac = WSP(float, MS_R2);
          S.preload();
          pg8::EpiBf16<2> E{WSP(bf16, WS_G), 1024, WSP(float, MS_R2), 1.f / (S8_H1 * S8_W), 0};
          int k8 = 512; asm volatile("" : "+s"(k8));
          pg8::gemm_phase_fp8<true>(F.lds, k8, S, E); }
    }
    SEAM(11);
    if (IN(12)) p10_rows(F);
#undef IN
#undef SEAM
}

extern "C" void kernel_launch(void* const* d_in, const int* in_sizes, int n_in, void* d_out, int out_size, void* d_ws, size_t ws_size, hipStream_t stream) {
    static int ready = 0, one_launch = 1;
    if (ready == 0) {
        if (n_in != 22 || out_size != T * D || ws_size < WS_END) { fprintf(stderr, "kernel_launch: unexpected shapes (n_in %d, out %d, ws %zu)\n", n_in, out_size, ws_size); ready = -1; return; }
        if (hipFuncSetAttribute((const void*)hymba_fwd, hipFuncAttributeMaxDynamicSharedMemorySize, LDS_BYTES) != hipSuccess) { fprintf(stderr, "kernel_launch: hipFuncSetAttribute failed\n"); ready = -1; return; }
        int dev = 0, cus = 0, per_cu = 0;
        if (hipGetDevice(&dev) != hipSuccess || hipDeviceGetAttribute(&cus, hipDeviceAttributeMultiprocessorCount, dev) != hipSuccess) cus = 0;
        if (hipOccupancyMaxActiveBlocksPerMultiprocessor(&per_cu, (const void*)hymba_fwd, NTHR, LDS_BYTES) != hipSuccess) per_cu = 0;
        (void)hipGetLastError();
        one_launch = (N_LAUNCHES == 1) && cus >= 256 && per_cu >= 1;
        if (!one_launch && N_LAUNCHES == 1) fprintf(stderr, "kernel_launch: %d CUs, %d blocks per CU: falling back to one launch per phase\n", cus, per_cu);
        ready = 1;
    }
    if (ready < 0) return;
    (void)hipMemsetAsync((char*)d_ws + WS_CTL, 0, CTL_ZERO_BYTES, stream);
    Args a{};
    for (int i = 0; i < 22; ++i) a.in[i] = (const float*)d_in[i];
    a.out = (float*)d_out; a.ws = (unsigned char*)d_ws;
    if (one_launch) {
        a.ph_lo = 0; a.ph_hi = NPH;
        hipLaunchKernelGGL(hymba_fwd, dim3(256), dim3(NTHR), LDS_BYTES, stream, a);
    } else {
        for (int p = 0; p < NPH; ++p) { a.ph_lo = p; a.ph_hi = p + 1; hipLaunchKernelGGL(hymba_fwd, dim3(256), dim3(NTHR), LDS_BYTES, stream, a);
        }
    }
}
```
